# Optimizing an MI355X kernel written in HIP

```python
import math
import jax
import jax.numpy as jnp
from jax import lax
import numpy as np

D_MODEL = 1024
BATCH = 16
SEQ = 4096
DEPTH = 4

GRID_W = 64
CTX_LEN = 256
N_MIXERS = 2
N_ATTN_LAYERS = (DEPTH + 1) // 2
N_RWKV_LAYERS = DEPTH // 2

DA_HEAD_DIM = 64
DA_HEADS = D_MODEL // (2 * DA_HEAD_DIM)
ROPE_THETA = 10000.0
Q_BLOCK = 128

RW_HEAD = 64
RW_HEADS = D_MODEL // RW_HEAD
LORA_W = 64
LORA_A = 64
LORA_V = 32
LORA_G = 128
N_SHIFT_MIX = 6
LNX_EPS = 64e-5

D_FF = 2816

EPS = 1e-6

kernel_name = 'hybrid_diffattn_rwkv7_convglu_dit'


def rms_norm(x, g, eps=EPS):
    xf = x.astype(jnp.float32)
    y = xf * lax.rsqrt(jnp.mean(xf * xf, axis=-1, keepdims=True) + eps)
    return (y * g.astype(jnp.float32)).astype(x.dtype)


def modulate(h, shift, scale):
    return h * (1 + scale) + shift


def shift_prev(t):
    return jnp.pad(t, ((0, 0), (1, 0), (0, 0)))[:, :-1]


def shift_next(t):
    return jnp.pad(t, ((0, 0), (0, 1), (0, 0)))[:, 1:]


def axial_rope_tables(rows, dtype):
    n_tok = rows * GRID_W
    t = jnp.arange(n_tok)
    row_pos = (t // GRID_W).astype(jnp.float32)
    col_pos = (t % GRID_W).astype(jnp.float32)
    n_freq = DA_HEAD_DIM // 4
    inv_freq = ROPE_THETA ** (-jnp.arange(n_freq, dtype=jnp.float32) / n_freq)
    ang = jnp.concatenate([row_pos[:, None] * inv_freq, col_pos[:, None] * inv_freq], axis=-1)
    return jnp.cos(ang).astype(dtype), jnp.sin(ang).astype(dtype)


def apply_rope(t, cos, sin):
    half = DA_HEAD_DIM // 2
    t1, t2 = t[..., :half], t[..., half:]
    return jnp.concatenate([t1 * cos - t2 * sin, t2 * cos + t1 * sin], axis=-1)


def diff_attend(q, k, v, lam):
    s = jnp.einsum('bqhcd,bkhcd->bhcqk', q, k).astype(jnp.float32) * (DA_HEAD_DIM ** -0.5)
    p = jax.nn.softmax(s, axis=-1)
    w = p[:, :, 0] - lam * p[:, :, 1]
    return jnp.einsum('bhqk,bkhe->bqhe', w.astype(v.dtype), v)


def diff_attention(h_lat, h_ctx, cos, sin, w_qkv, lam_vecs, subln_g, w_o, lambda_init, ctx_out):
    def project(h):
        b, n, _ = h.shape
        q, k, v = jnp.split(h @ w_qkv, 3, axis=-1)
        return (q.reshape(b, n, DA_HEADS, 2, DA_HEAD_DIM),
                k.reshape(b, n, DA_HEADS, 2, DA_HEAD_DIM),
                v.reshape(b, n, DA_HEADS, 2 * DA_HEAD_DIM))

    lv = lam_vecs.astype(jnp.float32)
    lam = jnp.exp(jnp.sum(lv[0] * lv[1])) - jnp.exp(jnp.sum(lv[2] * lv[3])) + lambda_init

    def finish(o):
        b, n = o.shape[:2]
        o = rms_norm(o, subln_g) * (1.0 - lambda_init)
        return o.reshape(b, n, D_MODEL) @ w_o

    q_c, k_c, v_c = project(h_ctx)
    q_l, k_l, v_l = project(h_lat)
    rc, rs = cos[None, :, None, None, :], sin[None, :, None, None, :]
    q_l = apply_rope(q_l, rc, rs)
    k_l = apply_rope(k_l, rc, rs)
    k_all = jnp.concatenate([k_c, k_l], axis=1)
    v_all = jnp.concatenate([v_c, v_l], axis=1)

    b, n = h_lat.shape[:2]
    n_blk = n // Q_BLOCK
    q_blocks = jnp.moveaxis(q_l.reshape(b, n_blk, Q_BLOCK, DA_HEADS, 2, DA_HEAD_DIM), 1, 0)
    o_blocks = lax.map(lambda qb: diff_attend(qb, k_all, v_all, lam), q_blocks)
    o_l = jnp.moveaxis(o_blocks, 0, 1).reshape(b, n, DA_HEADS, 2 * DA_HEAD_DIM)
    out_lat = finish(o_l)
    out_ctx = finish(diff_attend(q_c, k_c, v_c, lam)) if ctx_out else None
    return out_lat, out_ctx


def wkv_scan(r, w, k, v, a, b, s0, reverse):
    emit = r is not None
    to_time = lambda t: jnp.moveaxis(t.astype(jnp.float32), 1, 0)
    xs = tuple(to_time(t) for t in (w, k, v, a, b)) + ((to_time(r),) if emit else ())

    def step(S, inp):
        w_t, k_t, v_t, a_t, b_t = inp[:5]
        Sa = jnp.einsum('bhvk,bhk->bhv', S, a_t)
        S = (S * w_t[:, :, None, :] + Sa[..., None] * b_t[:, :, None, :]
             + v_t[..., None] * k_t[:, :, None, :])
        y = jnp.einsum('bhvk,bhk->bhv', S, inp[5]) if emit else None
        return S, y

    S, ys = lax.scan(step, s0, xs, reverse=reverse)
    return S, (jnp.moveaxis(ys, 0, 1) if emit else None)


def group_norm_heads(y, g, b):
    yf = y.astype(jnp.float32)
    mu = jnp.mean(yf, axis=-1, keepdims=True)
    var = jnp.mean(jnp.square(yf - mu), axis=-1, keepdims=True)
    yn = (yf - mu) * lax.rsqrt(var + LNX_EPS)
    return (yn * g.astype(jnp.float32).reshape(RW_HEADS, RW_HEAD)
            + b.astype(jnp.float32).reshape(RW_HEADS, RW_HEAD))


def rwkv7_bidir(h, p, v_first, s0, emit):
    b, n, _ = h.shape
    heads = lambda t: t.reshape(b, n, RW_HEADS, RW_HEAD)
    xx_p = shift_prev(h) - h
    xx_n = shift_next(h) - h
    xr, xw, xk, xv, xa, xg = (h + xx_p * p['mix_prev'][m] + xx_n * p['mix_next'][m]
                              for m in range(N_SHIFT_MIX))
    k = xk @ p['w_k']
    v = xv @ p['w_v']
    if v_first is None:
        v_first = v
    else:
        v = v + (v_first - v) * jax.nn.sigmoid(p['v0'] + (xv @ p['v1']) @ p['v2'])
    kk = heads(k * p['k_k']).astype(jnp.float32)
    kk = kk / jnp.maximum(jnp.sqrt(jnp.sum(kk * kk, axis=-1, keepdims=True)), 1e-12)
    r = heads(xr @ p['w_r']) if emit else None
    states, ys, keys = [], [], []
    for d, reverse in enumerate((False, True)):
        w_log = -jax.nn.softplus(-(p['w0'][d] + jnp.tanh(xw @ p['w1'][d]) @ p['w2'][d]).astype(jnp.float32)) - 0.5
        decay = jnp.exp(-jnp.exp(w_log))
        a = jax.nn.sigmoid(p['a0'][d] + (xa @ p['a1'][d]) @ p['a2'][d])
        k_d = heads(k * (1 + (a - 1) * p['k_a']))
        S, y = wkv_scan(r, heads(decay), k_d, heads(v), -kk, kk * heads(a), s0[d], reverse)
        states.append(S)
        ys.append(y)
        keys.append(k_d)
    new_states = (states[0], states[1])
    if not emit:
        return None, new_states, v_first
    y = group_norm_heads(ys[0] + ys[1], p['lnx_g'], p['lnx_b']).astype(h.dtype)
    bonus = (jnp.sum(r * keys[0] * p['r_k'], axis=-1, keepdims=True)
             + jnp.sum(r * keys[1] * p['r_k'], axis=-1, keepdims=True)) * heads(v)
    g = jax.nn.sigmoid(xg @ p['g1']) @ p['g2']
    out = ((y + bonus).reshape(b, n, D_MODEL) * g) @ p['w_o']
    return out, new_states, v_first


def conv_glu(h, w_up, conv_w, conv_b, w_down):
    gate, val = jnp.split(h @ w_up, 2, axis=-1)
    gate = shift_prev(gate) * conv_w[0] + gate * conv_w[1] + shift_next(gate) * conv_w[2] + conv_b
    return (jax.nn.silu(gate) * val) @ w_down


def setup_inputs(seed: int = 0) -> dict:
    key = jax.random.key(seed)
    ks = iter(jax.random.split(key, 64))
    nrm = lambda shape, scale: jax.random.normal(next(ks), shape, jnp.float32) * scale
    unif = lambda shape, lo, hi: jax.random.uniform(next(ks), shape, jnp.float32, lo, hi)
    D, L, NA, NR = D_MODEL, DEPTH, N_ATTN_LAYERS, N_RWKV_LAYERS
    return {
        'x': nrm((BATCH, SEQ, D), 1.0),
        'c': nrm((BATCH, D), 1.0),
        'ctx': nrm((BATCH, CTX_LEN, D), 1.0),
        'c_ctx': nrm((D,), 1.0),
        'ada_w': nrm((L, D, 6 * D), 0.5 * D ** -0.5),
        'ada_b': nrm((L, 6 * D), 0.02),
        'norm_mix_g': 1.0 + nrm((L, D), 0.02),
        'norm_ffn_g': 1.0 + nrm((L, D), 0.02),
        'ffn_w_up': nrm((L, D, 2 * D_FF), D ** -0.5),
        'ffn_conv_w': nrm((L, 3, D_FF), 3 ** -0.5),
        'ffn_conv_b': nrm((L, D_FF), 0.02),
        'ffn_w_down': nrm((L, D_FF, D), D_FF ** -0.5),
        'da_w_qkv': nrm((NA, D, 3 * D), D ** -0.5),
        'da_lambda': nrm((NA, 4, DA_HEAD_DIM), 0.1),
        'da_subln_g': 1.0 + nrm((NA, 2 * DA_HEAD_DIM), 0.02),
        'da_w_o': nrm((NA, D, D), D ** -0.5),
        'rw_mix_prev': unif((NR, N_SHIFT_MIX, D), 0.0, 0.6),
        'rw_mix_next': unif((NR, N_SHIFT_MIX, D), 0.0, 0.6),
        'rw_w_r': nrm((NR, D, D), D ** -0.5),
        'rw_w_k': nrm((NR, D, D), D ** -0.5),
        'rw_w_v': nrm((NR, D, D), D ** -0.5),
        'rw_w0': unif((NR, 2, D), -6.0, 0.0),
        'rw_w1': nrm((NR, 2, D, LORA_W), D ** -0.5),
        'rw_w2': nrm((NR, 2, LORA_W, D), 0.5 * LORA_W ** -0.5),
        'rw_a0': nrm((NR, 2, D), 0.5),
        'rw_a1': nrm((NR, 2, D, LORA_A), D ** -0.5),
        'rw_a2': nrm((NR, 2, LORA_A, D), 0.5 * LORA_A ** -0.5),
        'rw_v0': nrm((NR - 1, D), 0.5),
        'rw_v1': nrm((NR - 1, D, LORA_V), D ** -0.5),
        'rw_v2': nrm((NR - 1, LORA_V, D), 0.5 * LORA_V ** -0.5),
        'rw_k_k': 0.85 + nrm((NR, D), 0.05),
        'rw_k_a': 1.0 + nrm((NR, D), 0.05),
        'rw_r_k': nrm((NR, RW_HEADS, RW_HEAD), 0.1),
        'rw_g1': nrm((NR, D, LORA_G), D ** -0.5),
        'rw_g2': nrm((NR, LORA_G, D), LORA_G ** -0.5),
        'rw_lnx_g': 1.0 + nrm((NR, D), 0.02),
        'rw_lnx_b': nrm((NR, D), 0.02),
        'rw_w_o': nrm((NR, D, D), D ** -0.5),
        'final_norm_g': 1.0 + nrm((D,), 0.02),
    }


def reference(x, c, ctx, c_ctx, ada_w, ada_b, norm_mix_g, norm_ffn_g,
              ffn_w_up, ffn_conv_w, ffn_conv_b, ffn_w_down,
              da_w_qkv, da_lambda, da_subln_g, da_w_o,
              rw_mix_prev, rw_mix_next, rw_w_r, rw_w_k, rw_w_v, rw_w0, rw_w1, rw_w2,
              rw_a0, rw_a1, rw_a2, rw_v0, rw_v1, rw_v2, rw_k_k, rw_k_a, rw_r_k,
              rw_g1, rw_g2, rw_lnx_g, rw_lnx_b, rw_w_o, final_norm_g):
    B, T, _ = x.shape
    ROWS = T // GRID_W
    cos, sin = axial_rope_tables(ROWS, x.dtype)
    silu_c = jax.nn.silu(c)
    silu_cc = jax.nn.silu(c_ctx)
    v_first_lat = None
    v_first_ctx = None
    for i in range(DEPTH):
        last = i == DEPTH - 1
        j = i // N_MIXERS
        mod_l = jnp.split((silu_c @ ada_w[i] + ada_b[i])[:, None, :], 6, axis=-1)
        mod_c = jnp.split(silu_cc @ ada_w[i] + ada_b[i], 6, axis=-1)
        hl = modulate(rms_norm(x, norm_mix_g[i]), mod_l[0], mod_l[1])
        hc = modulate(rms_norm(ctx, norm_mix_g[i]), mod_c[0], mod_c[1])
        if i % N_MIXERS == 0:
            lambda_init = 0.8 - 0.6 * math.exp(-0.3 * i)
            out_l, out_c = diff_attention(hl, hc, cos, sin, da_w_qkv[j], da_lambda[j], da_subln_g[j],
                                          da_w_o[j], lambda_init, not last)
        else:
            p = dict(mix_prev=rw_mix_prev[j], mix_next=rw_mix_next[j], w_r=rw_w_r[j], w_k=rw_w_k[j],
                     w_v=rw_w_v[j], w0=rw_w0[j], w1=rw_w1[j], w2=rw_w2[j], a0=rw_a0[j], a1=rw_a1[j],
                     a2=rw_a2[j], k_k=rw_k_k[j], k_a=rw_k_a[j], r_k=rw_r_k[j], g1=rw_g1[j], g2=rw_g2[j],
                     lnx_g=rw_lnx_g[j], lnx_b=rw_lnx_b[j], w_o=rw_w_o[j])
            if j > 0:
                p.update(v0=rw_v0[j - 1], v1=rw_v1[j - 1], v2=rw_v2[j - 1])
            zero = jnp.zeros((B, RW_HEADS, RW_HEAD, RW_HEAD), jnp.float32)
            out_c, s_ctx, v_first_ctx = rwkv7_bidir(hc, p, v_first_ctx, (zero, zero), not last)
            out_l, _, v_first_lat = rwkv7_bidir(hl, p, v_first_lat, s_ctx, True)
        x = x + mod_l[2] * out_l
        hf = modulate(rms_norm(x, norm_ffn_g[i]), mod_l[3], mod_l[4])
        x = x + mod_l[5] * conv_glu(hf, ffn_w_up[i], ffn_conv_w[i], ffn_conv_b[i], ffn_w_down[i])
        if not last:
            ctx = ctx + mod_c[2] * out_c
            hfc = modulate(rms_norm(ctx, norm_ffn_g[i]), mod_c[3], mod_c[4])
            ctx = ctx + mod_c[5] * conv_glu(hfc, ffn_w_up[i], ffn_conv_w[i], ffn_conv_b[i], ffn_w_down[i])
    return rms_norm(x, final_norm_g)
```

```cpp
#include <hip/hip_runtime.h>
#include <hip/hip_cooperative_groups.h>
#include <cstdio>
#include <cstdint>
#include <cstring>
namespace cg = cooperative_groups;

#define LAS __attribute__((address_space(3)))
typedef unsigned short bf16_t;
typedef short bf16x8 __attribute__((ext_vector_type(8)));
typedef short s16x4 __attribute__((ext_vector_type(4)));
typedef float f32x4 __attribute__((ext_vector_type(4)));
typedef float f32x2 __attribute__((ext_vector_type(2)));
typedef float f32x16 __attribute__((ext_vector_type(16)));
typedef unsigned u32x4 __attribute__((ext_vector_type(4)));
typedef unsigned u32x2 __attribute__((ext_vector_type(2)));

constexpr int DM = 1024, NB = 16, TL = 4096, TC = 256, PB = TL + TC  , MR = NB * PB  ;
constexpr int DFF = 2816, NLAYER = 4;
constexpr int NWAVES = 8, NTHR = 512;
constexpr int LDS_BYTES = 155648;
constexpr size_t MiB = 1u << 20;
constexpr size_t WS_ROPE = 0;
constexpr size_t WS_BAR = 64 * 1024;
constexpr size_t WS_MOD = 1 * MiB;
constexpr size_t WS_KNORM = 3 * MiB;
constexpr size_t WS_W = 16 * MiB;
constexpr size_t WS_CTXR = 120 * MiB;
constexpr size_t WS_VF = 136 * MiB;
constexpr size_t WS_A0 = 272 * MiB, ABLK = 136 * MiB;
constexpr size_t WS_A1 = WS_A0 + ABLK, WS_A2 = WS_A1 + ABLK, WS_A3 = WS_A2 + ABLK, WS_A4 = WS_A3 + ABLK;
constexpr size_t WS_LORA = 952 * MiB;
constexpr size_t LORA_SZ = 17 * MiB;
constexpr size_t WS_END = 1020 * MiB;
constexpr size_t WS_CB2 = (size_t)(7.5 * 1048576.0);

__device__ __forceinline__ int tid_() { int t = threadIdx.x; asm volatile("" : "+v"(t)); return t; }
__device__ __forceinline__ int bid_() { int b = blockIdx.x; asm volatile("" : "+s"(b)); return b; }
__device__ __forceinline__ int gdim_() { int g = gridDim.x; asm volatile("" : "+s"(g)); return g; }
__device__ __forceinline__ unsigned cvt_pk_bf16(float lo, float hi) { unsigned r; asm volatile("v_cvt_pk_bf16_f32 %0, %1, %2" : "=v"(r) : "v"(lo), "v"(hi)); return r; }
__device__ __forceinline__ float bflo(unsigned w) { return __uint_as_float(w << 16); }
__device__ __forceinline__ float bfhi(unsigned w) { return __uint_as_float(w & 0xffff0000u); }
__device__ __forceinline__ float bf2f(bf16_t h) { return __uint_as_float((unsigned)h << 16); }
__device__ __forceinline__ float wave_sum(float v) {
#pragma unroll
    for (int o = 1; o < 64; o <<= 1) v += __shfl_xor(v, o);
    return v;
}
__device__ __forceinline__ float dpp_f(float x, const int ctrl_dummy) { return x; }
#define DPP_ADD(x, ctrl) ((x) + __int_as_float(__builtin_amdgcn_update_dpp(0, __float_as_int(x), (ctrl), 0xF, 0xF, true)))
__device__ __forceinline__ float red4(float x) { x = DPP_ADD(x, 0xB1); x = DPP_ADD(x, 0x4E); return x; }
__device__ __forceinline__ float red8(float x) { x = red4(x); x = DPP_ADD(x, 0x141); return x; }
__device__ __forceinline__ float red16(float x) { x = red8(x); x = DPP_ADD(x, 0x140); return x; }
__device__ __forceinline__ float sigmoidf_(float x) { return __builtin_amdgcn_rcpf(1.f + __expf(-x)); }
__device__ __forceinline__ void unpack8(u32x4 w, float* f) { f[0] = bflo(w.x); f[1] = bfhi(w.x); f[2] = bflo(w.y); f[3] = bfhi(w.y); f[4] = bflo(w.z); f[5] = bfhi(w.z); f[6] = bflo(w.w); f[7] = bfhi(w.w); }
__device__ __forceinline__ u32x4 pack8(const float* f) { u32x4 w; w.x = cvt_pk_bf16(f[0], f[1]); w.y = cvt_pk_bf16(f[2], f[3]); w.z = cvt_pk_bf16(f[4], f[5]); w.w = cvt_pk_bf16(f[6], f[7]); return w; }


#define XB_TMO      128
#define XB_XCNT(j)  (256  + 64 * (j))
#define XB_XSUB(j)  (1280 + 64 * (j))
#define XB_XGEN(j)  (2304 + 64 * (j))
#define XB_TOP      3328
#define XB_TOPGEN   3392
#define XCD_BAR_WORDS 3456
#define XB_SPIN_CAP (1u << 22)
__device__ __forceinline__ unsigned xb_ld(unsigned* p)              { return __hip_atomic_load(p, __ATOMIC_RELAXED, __HIP_MEMORY_SCOPE_AGENT); }
__device__ __forceinline__ unsigned xb_add(unsigned* p, unsigned v) { return __hip_atomic_fetch_add(p, v, __ATOMIC_RELAXED, __HIP_MEMORY_SCOPE_AGENT); }
__device__ __forceinline__ unsigned xb_xcc_id() { return (unsigned)__builtin_amdgcn_s_getreg((3 << 11) | 20) & 0xFu; }
#define XB_SPIN(cond, bar) do { unsigned _sp = 0; while (cond) { __builtin_amdgcn_s_sleep(1); \
    if ((++_sp & 255u) == 0u) { if (xb_ld(&(bar)[XB_TMO])) break; if (_sp > XB_SPIN_CAP) { atomicAdd(&(bar)[XB_TMO], 1u); break; } } } } while (0)
struct XcdBarrier { unsigned* bar; unsigned x; volatile LAS unsigned* st; };
__device__ __forceinline__ XcdBarrier xcd_barrier_post(unsigned* bar, volatile LAS unsigned* st) {
    XcdBarrier b; b.bar = bar; b.x = xb_xcc_id(); b.st = st;
    if (threadIdx.x == 0) (void)xb_add(&bar[XB_XCNT(b.x)], 1u);
    return b;
}
__device__ __forceinline__ void xcd_barrier_complete(unsigned* bar, unsigned x, unsigned& nloc, unsigned& nx) {
    const unsigned G = gridDim.x * gridDim.y * gridDim.z;
    unsigned sum, cnt, mine, sp = 0u;
    for (;;) {
        sum = 0u; cnt = 0u; mine = 0u;
#pragma unroll
        for (unsigned j = 0; j < 16; ++j) { const unsigned c = xb_ld(&bar[XB_XCNT(j)]); sum += c; cnt += (c > 0u) ? 1u : 0u; mine = (j == x) ? c : mine; }
        if (sum == G) break;
        __builtin_amdgcn_s_sleep(1);
        if ((++sp & 255u) == 0u) { if (xb_ld(&bar[XB_TMO])) break; if (sp > XB_SPIN_CAP) { atomicAdd(&bar[XB_TMO], 1u); break; } }
    }
    nloc = mine > 0u ? mine : 1u; nx = cnt > 0u ? cnt : 1u;
}
__device__ __forceinline__ void xcd_barrier(const XcdBarrier& b) {
    asm volatile("s_waitcnt vmcnt(0)" ::: "memory");
    __syncthreads();
    if (threadIdx.x == 0) {
        unsigned* bar = b.bar;
        __builtin_amdgcn_s_waitcnt(0);
        unsigned nloc = b.st[0], nx = b.st[1];
        if (nloc == 0u) { xcd_barrier_complete(bar, b.x, nloc, nx); b.st[0] = nloc; b.st[1] = nx; }
        const unsigned old = xb_add(&bar[XB_XSUB(b.x)], 1u);
        const unsigned gen = old / nloc;
        if (old + 1u == (gen + 1u) * nloc) {
            __builtin_amdgcn_fence(__ATOMIC_RELEASE, "agent");
            asm volatile("s_waitcnt vmcnt(0)" ::: "memory");
            const unsigned og = xb_add(&bar[XB_TOP], 1u);
            const unsigned tg = og / nx;
            if (og + 1u == (tg + 1u) * nx) xb_add(&bar[XB_TOPGEN], 1u);
            else XB_SPIN(xb_ld(&bar[XB_TOPGEN]) == tg, bar);
            __builtin_amdgcn_fence(__ATOMIC_ACQUIRE, "agent");
            xb_add(&bar[XB_XGEN(b.x)], 1u);
            asm volatile("s_waitcnt vmcnt(0)" ::: "memory");
        } else {
            XB_SPIN(xb_ld(&bar[XB_XGEN(b.x)]) == gen, bar);
            __builtin_amdgcn_fence(__ATOMIC_ACQUIRE, "agent");
            asm volatile("s_waitcnt vmcnt(0)" ::: "memory");
        }
    }
    __syncthreads();
}

namespace pg8 {
constexpr int BM = 256, BK = 64, HALF = 128, HTB = HALF * BK * 2, STAGE_BYTES = 8 * HTB, NXCD = 8, WGM = 8;
__host__ __device__ __forceinline__ int lds_byte(int r, int c) { const int st = (r >> 4) * 2 + (c >> 5), rr = r & 15, cc = c & 31, ob = rr * 64 + cc * 2; return st * 1024 + (ob ^ (((ob >> 9) & 1) << 5)); }
__host__ __device__ __forceinline__ void stage_rc(int b, int& R, int& C) { const int st = b / 1024, sb = b % 1024, swz = sb ^ (((sb >> 9) & 1) << 5); R = (st >> 1) * 16 + swz / 64; C = (st & 1) * 32 + (swz % 64) / 2; }
__host__ __device__ __forceinline__ int perm32(int rho) { const int n = rho >> 4, i = rho & 15; return 8 * (i >> 2) + 4 * n + (i & 3); }
struct Unit { int pm, pn; };
struct Gemm { const bf16_t* A; const bf16_t* Bt; int M, N, K, lda, ldb; int rot, lat_only; };
struct StaticOrder {
    int nM, nN, nwg, G, c, lat;
    __device__ void init(int M, int N, int G_, int c_, int lat_) { nM = M / BM; nN = N / BM; nwg = nM * nN; G = G_; c = c_; lat = lat_; }
    __device__ bool next(int i, Unit& u) const {
        const long L = (long)i * G + c; if (L >= nwg) return false;
        int wgid = (int)L; { const int q = nwg / NXCD, r = nwg % NXCD, xcd = wgid % NXCD, off = wgid / NXCD; wgid = (xcd < r ? xcd * (q + 1) : r * (q + 1) + (xcd - r) * q) + off; }
        const int nig = WGM * nN, gid = wgid / nig, fm = gid * WGM, gsz = (nM - fm) < WGM ? (nM - fm) : WGM;
        u.pm = fm + ((wgid % nig) % gsz); u.pn = (wgid % nig) / gsz;
        if (lat) u.pm = (u.pm >> 4) * 17 + 1 + (u.pm & 15);
        return true;
    }
};
template <class Epi>
__device__ __forceinline__ void gemm_phase(LAS unsigned char* lds, const Gemm g, const Epi& E) {
    StaticOrder S; { const int G_ = gdim_(); int c_ = bid_() + g.rot; if (c_ >= G_) c_ -= G_; S.init(g.M, g.N, G_, c_, g.lat_only); }
    const int tid = tid_(), wid = __builtin_amdgcn_readfirstlane(tid >> 6), lane = tid & 63, wr = wid >> 2, wc = wid & 3, fr = lane & 15, fq = lane >> 4;
    const int K = g.K, nt = K / BK;
    unsigned voffA[2], voffB[2];
#pragma unroll
    for (int i = 0; i < 2; ++i) { int R, C; stage_rc(tid * 16 + i * 8192, R, C); const int Rb = (R & ~31) + perm32(R & 31);
        voffA[i] = (unsigned)(R * g.lda + C) * 2u; voffB[i] = (unsigned)(Rb * g.ldb + C) * 2u; }
    const size_t kstep = (size_t)(BK * 2);
    const size_t hstepA = (size_t)HALF * g.lda * 2, hstepB = (size_t)HALF * g.ldb * 2;
    const size_t tstepA = 2 * hstepA, tstepB = 2 * hstepB;
    const unsigned ldsw = (unsigned)wid * 1024u;
    const int aoff = lds_byte(wr * 64 + fr, fq * 8), boff = lds_byte(wc * 32 + fr, fq * 8);
#define PG8_SA(b, h) (((b) * 2 + (h)) * HTB)
#define PG8_SB(b, h) ((4 + (b) * 2 + (h)) * HTB)
#define PG8_STAGE(bufoff, gbase, voff) do { _Pragma("unroll") for (int _i = 0; _i < 2; ++_i) \
        __builtin_amdgcn_global_load_lds((const unsigned*)((const char*)(gbase) + (voff)[_i]), (LAS unsigned*)(lds + (bufoff) + ldsw + _i * 8192), 16, 0, 0); } while (0)
#define PG8_LDA(dst, b, h) do { _Pragma("unroll") for (int m = 0; m < 4; ++m) _Pragma("unroll") for (int k = 0; k < 2; ++k) dst[m][k] = *(const LAS bf16x8*)(lds + PG8_SA(b, h) + aoff + m * 2048 + k * 1024); } while (0)
#define PG8_LDB(dst, b, h) do { _Pragma("unroll") for (int n = 0; n < 2; ++n) _Pragma("unroll") for (int k = 0; k < 2; ++k) dst[n][k] = *(const LAS bf16x8*)(lds + PG8_SB(b, h) + boff + n * 2048 + k * 1024); } while (0)
#define PG8_MMA(ai, bj, At, Bt) do { __builtin_amdgcn_s_setprio(1); _Pragma("unroll") for (int m = 0; m < 4; ++m) _Pragma("unroll") for (int n = 0; n < 2; ++n) _Pragma("unroll") for (int k = 0; k < 2; ++k) \
        acc[ai][bj][m][n] = __builtin_amdgcn_mfma_f32_16x16x32_bf16(Bt[n][k], At[m][k], acc[ai][bj][m][n], 0, 0, 0); __builtin_amdgcn_s_setprio(0); } while (0)
#define PG8_WAIT_V(n) asm volatile("s_waitcnt vmcnt(" #n ")" ::: "memory")
#define PG8_WAIT_L(n) asm volatile("s_waitcnt lgkmcnt(" #n ")" ::: "memory")
#define PG8_BAR __builtin_amdgcn_s_barrier()
#define PG8_SCHED __builtin_amdgcn_sched_barrier(0)
    Unit cur, nxt; int ui = 0;
    if (!S.next(0, cur)) return;
    f32x4 acc[2][2][4][2];
#pragma unroll
    for (int a = 0; a < 2; ++a)
#pragma unroll
        for (int b = 0; b < 2; ++b)
#pragma unroll
            for (int m = 0; m < 4; ++m)
#pragma unroll
                for (int n = 0; n < 2; ++n) acc[a][b][m][n] = (f32x4){0.f, 0.f, 0.f, 0.f};
    bf16x8 At[4][2], B0[2][2], B1[2][2];
    const char* cA = (const char*)g.A + (size_t)cur.pm * tstepA; const char* cB = (const char*)g.Bt + (size_t)cur.pn * tstepB;
    PG8_STAGE(PG8_SB(0, 0), cB, voffB); PG8_STAGE(PG8_SB(0, 1), cB + hstepB, voffB); PG8_STAGE(PG8_SA(0, 0), cA, voffA); PG8_STAGE(PG8_SA(0, 1), cA + hstepA, voffA);
    if (wr == 1) PG8_BAR;
    PG8_WAIT_V(2); PG8_BAR;
    PG8_STAGE(PG8_SB(1, 0), cB + kstep, voffB); PG8_STAGE(PG8_SA(1, 0), cA + kstep, voffA); PG8_STAGE(PG8_SB(1, 1), cB + hstepB + kstep, voffB);
    PG8_WAIT_V(6); PG8_BAR;
    for (;;) {
        const bool has_next = S.next(ui + 1, nxt);
        const char* nA = has_next ? (const char*)g.A + (size_t)nxt.pm * tstepA : cA; const char* nB = has_next ? (const char*)g.Bt + (size_t)nxt.pn * tstepB : cB;
        for (int t = 0; t < nt; t += 2) {
            const bool last = (t == nt - 2);
            const char* a1 = cA + (size_t)(t + 1) * kstep;
            const char* a2 = last ? nA : cA + (size_t)(t + 2) * kstep; const char* b2 = last ? nB : cB + (size_t)(t + 2) * kstep;
            const char* a3 = a2 + kstep; const char* b3 = b2 + kstep;
            PG8_LDB(B0, 0, 0); PG8_LDB(B1, 0, 1); PG8_SCHED; PG8_LDA(At, 0, 0); PG8_STAGE(PG8_SA(1, 1), a1 + hstepA, voffA);
            PG8_WAIT_V(8); PG8_WAIT_L(0); PG8_BAR; PG8_MMA(0, 0, At, B0); PG8_MMA(0, 1, At, B1); PG8_BAR; PG8_SCHED;
            PG8_LDA(At, 0, 1); PG8_STAGE(PG8_SB(0, 0), b2, voffB); PG8_STAGE(PG8_SB(0, 1), b2 + hstepB, voffB); PG8_STAGE(PG8_SA(0, 0), a2, voffA);
            PG8_WAIT_V(8); PG8_WAIT_L(0); PG8_BAR; PG8_MMA(1, 0, At, B0); PG8_MMA(1, 1, At, B1); PG8_BAR; PG8_SCHED;
            PG8_LDB(B0, 1, 0); PG8_LDB(B1, 1, 1); PG8_SCHED; PG8_LDA(At, 1, 0); PG8_STAGE(PG8_SA(0, 1), a2 + hstepA, voffA);
            PG8_WAIT_V(8); PG8_WAIT_L(0); PG8_BAR; PG8_MMA(0, 0, At, B0); PG8_MMA(0, 1, At, B1); PG8_BAR; PG8_SCHED;
            PG8_LDA(At, 1, 1); PG8_STAGE(PG8_SB(1, 0), b3, voffB); PG8_STAGE(PG8_SB(1, 1), b3 + hstepB, voffB); PG8_STAGE(PG8_SA(1, 0), a3, voffA);
            PG8_WAIT_V(8); PG8_WAIT_L(0); PG8_BAR; PG8_MMA(1, 0, At, B0); PG8_MMA(1, 1, At, B1); PG8_BAR; PG8_SCHED;
        }
        if (wr == 0) PG8_BAR;
        E(acc, cur, wr, wc, fr, fq);
        if (!has_next) break;
#pragma unroll
        for (int a = 0; a < 2; ++a)
#pragma unroll
            for (int b = 0; b < 2; ++b)
#pragma unroll
                for (int m = 0; m < 4; ++m)
#pragma unroll
                    for (int n = 0; n < 2; ++n) acc[a][b][m][n] = (f32x4){0.f, 0.f, 0.f, 0.f};
        cur = nxt; cA = nA; cB = nB; ++ui;
        if (wr == 1) PG8_BAR;
    }
    PG8_WAIT_V(0);
    PG8_BAR;
#undef PG8_SA
#undef PG8_SB
#undef PG8_STAGE
#undef PG8_LDA
#undef PG8_LDB
#undef PG8_MMA
#undef PG8_WAIT_V
#undef PG8_WAIT_L
#undef PG8_BAR
#undef PG8_SCHED
}
}

enum { EM_BF16 = 0, EM_QKV = 1, EM_RES = 2, EM_VMIX = 3, EM_MULZ = 4, EM_GLU = 5 };
struct EpiGen {
    int mode; bf16_t* O; bf16_t* O2; bf16_t* O3; const bf16_t* VFp; const float* f0; const float* f1; float* XL; float* XC; int ldc, nstore, act, k, row_off; unsigned ldsb;
    template <int mode> __device__ __forceinline__ void each(int row, int col, float* v) const {
        if (mode == EM_BF16) {
            if (col >= nstore) return;
            if (act == 1) { for (int i = 0; i < 8; ++i) v[i] = tanhf(v[i]); }
            else if (act == 2) { for (int i = 0; i < 8; ++i) v[i] = sigmoidf_(v[i]); }
            *(u32x4*)(O + (size_t)row * ldc + col) = pack8(v);
        } else if (mode == EM_QKV) {
            const int which = col >> 10, c = col & 1023;
            bf16_t* base = O + (size_t)which * (ABLK / 2);
            const int b = row / PB, p = row - b * PB;
            if (which < 2 && p >= TC) {
                const int t = p - TC; const int g = (c & 63) >> 3;
                const int pos = (g < 4) ? (t >> 6) : (t & 63); const int fo = (g & 3) * 4;
                const f32x4* rp = (const f32x4*)(f0 + (pos * 16 + fo) * 2);
                const f32x4 r0 = rp[0], r1 = rp[1];
                const f32x4 cs = {r0[0], r0[2], r1[0], r1[2]}, sn = {r0[1], r0[3], r1[1], r1[3]};
                const f32x4 t1 = {v[0], v[1], v[2], v[3]}, t2 = {v[4], v[5], v[6], v[7]};
                const f32x4 n1 = t1 * cs - t2 * sn, n2 = t2 * cs + t1 * sn;
                v[0] = n1[0]; v[1] = n1[1]; v[2] = n1[2]; v[3] = n1[3]; v[4] = n2[0]; v[5] = n2[1]; v[6] = n2[2]; v[7] = n2[3];
            }
            *(u32x4*)(base + (size_t)row * DM + c) = pack8(v);
        } else if (mode == EM_RES) {
            const int r = row + row_off; const int b = r / PB, p = r - b * PB;
            float* x; const float* md;
            if (p < TC) { x = XC + ((size_t)(b * TC + p)) * DM + col; md = f0 + (size_t)16 * 6144 + k * DM + col; }
            else { x = XL + ((size_t)(b * TL + p - TC)) * DM + col; md = f0 + (size_t)b * 6144 + k * DM + col; }
            f32x4 x0 = *(f32x4*)x, x1 = *(f32x4*)(x + 4); const f32x4 m0 = *(const f32x4*)md, m1 = *(const f32x4*)(md + 4);
            x0[0] += m0[0] * v[0]; x0[1] += m0[1] * v[1]; x0[2] += m0[2] * v[2]; x0[3] += m0[3] * v[3];
            x1[0] += m1[0] * v[4]; x1[1] += m1[1] * v[5]; x1[2] += m1[2] * v[6]; x1[3] += m1[3] * v[7];
            *(f32x4*)x = x0; *(f32x4*)(x + 4) = x1;
        } else if (mode == EM_VMIX) {
            float a[8], f[8]; unpack8(*(const u32x4*)(O + (size_t)row * DM + col), a); unpack8(*(const u32x4*)(VFp + (size_t)row * DM + col), f);
#pragma unroll
            for (int i = 0; i < 8; ++i) a[i] = a[i] + (f[i] - a[i]) * sigmoidf_(f0[col + i] + v[i]);
            *(u32x4*)(O + (size_t)row * DM + col) = pack8(a);
        } else {
            float a[8]; unpack8(*(const u32x4*)(O + (size_t)row * DM + col), a);
#pragma unroll
            for (int i = 0; i < 8; ++i) a[i] *= v[i];
            *(u32x4*)(O + (size_t)row * DM + col) = pack8(a);
        }
    }
    template <int MODE> __device__ __forceinline__ void run(const f32x4 (&acc)[2][2][4][2], const pg8::Unit& u, int wr, int wc, int fr, int fq) const {
        int fro = fr; asm volatile("" : "+v"(fro));
#pragma unroll
        for (int ai = 0; ai < 2; ++ai)
#pragma unroll
            for (int m = 0; m < 4; ++m) {
                const int row = u.pm * 256 + ai * 128 + wr * 64 + m * 16 + fro;
#pragma unroll
                for (int bj = 0; bj < 2; ++bj) {
                    const int col = u.pn * 256 + bj * 128 + wc * 32 + 8 * fq;
                    float v[8];
                    const f32x4 a0 = acc[ai][bj][m][0], a1 = acc[ai][bj][m][1];
                    v[0] = a0[0]; v[1] = a0[1]; v[2] = a0[2]; v[3] = a0[3]; v[4] = a1[0]; v[5] = a1[1]; v[6] = a1[2]; v[7] = a1[3];
                    each<MODE>(row, col, v);
                }
                asm volatile("" ::: "memory");
            }
    }
    __device__ __forceinline__ void run_glu(const f32x4 (&acc)[2][2][4][2], const pg8::Unit& u, int wr, int wc, int fr, int fq) const {
        LAS float* B = (LAS float*)((LAS unsigned char*)0 + ldsb);
        int fro = fr; asm volatile("" : "+v"(fro));
        int lidx = (wc * 2) * 16 + fq * 4; asm volatile("" : "+v"(lidx));
#pragma unroll
        for (int ai = 0; ai < 2; ++ai)
#pragma unroll
            for (int m = 0; m < 4; ++m) { const int g = ai * 8 + wr * 4 + m;
#pragma unroll
                for (int bj = 0; bj < 2; ++bj) {
                    if (fr == 0) *(LAS f32x4*)(B + (g * 2 + 0) * 128 + lidx + bj * 16) = acc[ai][bj][m][0];
                    if (fr == 15) *(LAS f32x4*)(B + (g * 2 + 1) * 128 + lidx + bj * 16) = acc[ai][bj][m][0];
                } }
        asm volatile("s_waitcnt lgkmcnt(0)" ::: "memory"); __builtin_amdgcn_s_barrier(); asm volatile("" ::: "memory");
        const int t17 = u.pm % 17; const bool tfirst = (t17 == 0) || (t17 == 1), tlast = (t17 == 0) || (t17 == 16);
#pragma unroll
        for (int bj = 0; bj < 2; ++bj) {
            int col = u.pn * 256 + bj * 128 + wc * 32 + 8 * fq; asm volatile("" : "+v"(col)); const int ch = (col >> 3) * 4;
            const f32x4 c0 = *(const f32x4*)(f0 + ch), c1 = *(const f32x4*)(f0 + DFF + ch), c2 = *(const f32x4*)(f0 + 2 * DFF + ch), cb = *(const f32x4*)(f1 + ch);
#pragma unroll
            for (int ai = 0; ai < 2; ++ai)
#pragma unroll
                for (int m = 0; m < 4; ++m) { const int g = ai * 8 + wr * 4 + m;
                    const int row = u.pm * 256 + g * 16 + fro;
                    const f32x4 gt = acc[ai][bj][m][0], vl = acc[ai][bj][m][1];
                    f32x4 gp, gn;
#pragma unroll
                    for (int i = 0; i < 4; ++i) { gp[i] = __int_as_float(__builtin_amdgcn_update_dpp(0, __float_as_int(gt[i]), 0x111, 0xF, 0xF, true));
                                                  gn[i] = __int_as_float(__builtin_amdgcn_update_dpp(0, __float_as_int(gt[i]), 0x101, 0xF, 0xF, true)); }
                    if (fr == 0) {
                        if (g > 0) gp = *(const LAS f32x4*)(B + ((g - 1) * 2 + 1) * 128 + lidx + bj * 16);
                        else if (!tfirst) { const u32x2 w = *(const u32x2*)(VFp + (size_t)(2 * (u.pm - 1)) * (2 * DFF) + col); gp = (f32x4){bflo(w.x), bfhi(w.x), bflo(w.y), bfhi(w.y)}; }
                        else gp = (f32x4){0.f, 0.f, 0.f, 0.f};
                    }
                    if (fr == 15) {
                        if (g < 15) gn = *(const LAS f32x4*)(B + ((g + 1) * 2 + 0) * 128 + lidx + bj * 16);
                        else if (!tlast) { const u32x2 w = *(const u32x2*)(VFp + (size_t)(2 * u.pm + 1) * (2 * DFF) + col); gn = (f32x4){bflo(w.x), bfhi(w.x), bflo(w.y), bfhi(w.y)}; }
                        else gn = (f32x4){0.f, 0.f, 0.f, 0.f};
                    }
                    float o[4];
#pragma unroll
                    for (int i = 0; i < 4; ++i) { const float x = gp[i] * c0[i] + gt[i] * c1[i] + gn[i] * c2[i] + cb[i]; o[i] = x * __builtin_amdgcn_rcpf(1.f + __expf(-x)) * vl[i]; }
                    u32x2 w; w.x = cvt_pk_bf16(o[0], o[1]); w.y = cvt_pk_bf16(o[2], o[3]);
                    *(u32x2*)(O + (size_t)row * DFF + ch) = w;
                    if (m & 1) asm volatile("" ::: "memory");
                }
        }
    }
    __device__ __forceinline__ void operator()(const f32x4 (&acc)[2][2][4][2], const pg8::Unit& u, int wr, int wc, int fr, int fq) const {
        switch (mode) {
        case EM_GLU: run_glu(acc, u, wr, wc, fr, fq); break;
        case EM_BF16: run<EM_BF16>(acc, u, wr, wc, fr, fq); break;
        case EM_QKV: run<EM_QKV>(acc, u, wr, wc, fr, fq); break;
        case EM_RES: run<EM_RES>(acc, u, wr, wc, fr, fq); break;
        case EM_VMIX: run<EM_VMIX>(acc, u, wr, wc, fr, fq); break;
        default: run<EM_MULZ>(acc, u, wr, wc, fr, fq); break;
        }
    }
};

struct TJob { const float* src; bf16_t* dst; int Ksrc, Kdst, Nsrc, Ndst, dld, perm; };
constexpr int MAXJOBS = 48;
struct Params { const float* in[39]; float* out; unsigned char* ws; int njobs; int pad; unsigned ws_lo, ws_hi; TJob jobs[MAXJOBS]; };

constexpr size_t W_QKV(int j) { return (size_t)j * 8 * MiB; }
constexpr size_t W_AO(int j) { return (size_t)j * 8 * MiB + 6 * MiB; }
constexpr size_t W_UP2(int i) { return 16 * MiB + (size_t)i * (33 * MiB / 2); }
constexpr size_t W_DN2(int i) { return W_UP2(i) + 11 * MiB; }
constexpr size_t W_RWB(int j) { return 82 * MiB + (size_t)j * 11 * MiB; }
constexpr size_t RW_R = 0, RW_K = 2 * MiB, RW_V = 4 * MiB, RW_O = 6 * MiB, RW_W1 = 8 * MiB, RW_A1 = RW_W1 + 512 * 1024, RW_G1 = RW_A1 + 512 * 1024, RW_V1 = RW_G1 + 512 * 1024,
                 RW_G2 = 10 * MiB, RW_V2 = RW_G2 + 256 * 1024, RW_W2 = RW_V2 + 256 * 1024, RW_A2 = RW_W2 + 256 * 1024;

__device__ __forceinline__ void p0_transpose_item(const TJob& J, LAS float* scr, int item, int lane) {
    const int nblk = J.Ndst / 32, kb = item / nblk, nb = item % nblk, k0 = 64 * kb, n0 = 32 * nb;
    const int n4 = (lane & 7) * 4, n = n0 + n4;
#pragma unroll
    for (int i = 0; i < 8; ++i) { const int kk = 8 * i + (lane >> 3); const int k = k0 + kk;
        f32x4 val = {0.f, 0.f, 0.f, 0.f}; if (k < J.Ksrc && n < J.Nsrc) val = *(const f32x4*)(J.src + (size_t)k * J.Nsrc + n);
        scr[kk * 33 + n4] = val[0]; scr[kk * 33 + n4 + 1] = val[1]; scr[kk * 33 + n4 + 2] = val[2]; scr[kk * 33 + n4 + 3] = val[3]; }
    asm volatile("s_waitcnt lgkmcnt(0)" ::: "memory");
    const int c = lane & 7;
#pragma unroll
    for (int j = 0; j < 4; ++j) { const int nl = (lane >> 3) + 8 * j; const LAS float* s = scr + (8 * c) * 33 + nl;
        u32x4 o; o.x = cvt_pk_bf16(s[0 * 33], s[1 * 33]); o.y = cvt_pk_bf16(s[2 * 33], s[3 * 33]); o.z = cvt_pk_bf16(s[4 * 33], s[5 * 33]); o.w = cvt_pk_bf16(s[6 * 33], s[7 * 33]);
        int nd = n0 + nl;
        if (J.perm == 1 && nd < 2048) { const int s6 = nd & 63, jj = s6 & 31; nd = (nd & ~63) + 8 * (jj >> 2) + (jj & 3) + ((s6 >> 5) << 2); }
        else if (J.perm == 2) { const int isv = nd >= DFF ? 1 : 0, ch = nd - isv * DFF; nd = (ch >> 2) * 8 + isv * 4 + (ch & 3); }
        *(u32x4*)(J.dst + (size_t)nd * J.dld + k0 + 8 * c) = o; }
    asm volatile("s_waitcnt lgkmcnt(0)" ::: "memory");
}

__device__ __forceinline__ void phase_p0(const Params& P, unsigned char* ws, LAS unsigned char* lds) {
    const int tid = tid_(), lane = tid & 63, wave = __builtin_amdgcn_readfirstlane(tid >> 6);
    const int G = gdim_();
    if (bid_() == 0) { for (int i = tid; i < 4096; i += NTHR) ((unsigned*)(ws + WS_BAR))[i] = 0u; }
    if (bid_() == 0) {
        for (int i = tid; i < 1024; i += NTHR) { const int pos = i >> 4, f = i & 15; const float inv = powf(10000.f, -(float)f / 16.f); const float ang = (float)pos * inv;
            ((f32x2*)(ws + WS_ROPE))[i] = (f32x2){cosf(ang), sinf(ang)}; }
    }
    {
        LAS float* scr = (LAS float*)(lds + wave * 16384);
        const int gw = bid_() * NWAVES + wave, NGW = G * NWAVES;
        int total = 0;
        for (int j = 0; j < P.njobs; ++j) total += (P.jobs[j].Kdst / 64) * (P.jobs[j].Ndst / 32);
        for (int it = gw; it < total; it += NGW) {
            int r = it, j = 0;
            for (; j < P.njobs; ++j) { const int c = (P.jobs[j].Kdst / 64) * (P.jobs[j].Ndst / 32); if (r < c) break; r -= c; }
            p0_transpose_item(P.jobs[j], scr, r, lane);
        }
    }
    __syncthreads();
    {
        LAS float* SV = (LAS float*)lds;
        LAS float* PART = (LAS float*)(lds + 17 * 4096);
        const float* cin = P.in[1]; const float* cctx = P.in[3];
        for (int i = tid; i < 17 * 1024; i += NTHR) { const int j = i >> 10, k = i & 1023; const float x = (j < 16) ? cin[j * 1024 + k] : cctx[k]; SV[i] = x / (1.f + __expf(-x)); }
        __syncthreads();
        for (int item = bid_(); item < NLAYER * 96; item += G) {
            const int l = item / 96, c0 = (item % 96) * 64;
            const float* W = P.in[4] + (size_t)l * 1024 * 6144 + c0 + lane;
            float acc[17];
#pragma unroll
            for (int j = 0; j < 17; ++j) acc[j] = 0.f;
            const int kbeg = wave * 128;
#pragma unroll 2
            for (int k = kbeg; k < kbeg + 128; ++k) { const float w = W[(size_t)k * 6144];
#pragma unroll
                for (int j = 0; j < 17; ++j) acc[j] += SV[j * 1024 + k] * w; }
#pragma unroll
            for (int j = 0; j < 17; ++j) PART[(wave * 17 + j) * 64 + lane] = acc[j];
            __syncthreads();
            for (int o = tid; o < 17 * 64; o += NTHR) { const int j = o >> 6, cc = o & 63; float s = 0.f;
#pragma unroll
                for (int w = 0; w < 8; ++w) s += PART[(w * 17 + j) * 64 + cc];
                ((float*)(ws + WS_MOD))[((size_t)l * 17 + j) * 6144 + c0 + cc] = s + P.in[5][(size_t)l * 6144 + c0 + cc]; }
            __syncthreads();
        }
    }
}

__device__ __forceinline__ size_t xrow_off(int m, bool& isc, int& key) { const int b = m / PB, p = m - b * PB; isc = p < TC; key = isc ? 16 : b; return isc ? ((size_t)(b * TC + p)) * DM : ((size_t)(b * TL + p - TC)) * DM; }
__device__ __forceinline__ void phase_norm_mod(const float* srcL, const float* srcC, float* cpL, float* cpC, const float* g, const float* mod  , int which, bf16_t* H, bf16_t* HB) {
    const int lane = tid_() & 63, wave = tid_() >> 6;
    const int gw = bid_() * NWAVES + wave, NGW = gdim_() * NWAVES;
    const int rpw = (MR + NGW - 1) / NGW; const int m0 = gw * rpw, m1 = (m0 + rpw < MR) ? (m0 + rpw) : MR;
    if (m0 >= m1) return;
    int curkey = -1; f32x4 gm[4], shv[4], v[4], vn[4], vnn[4];
    { bool isc; int key; const size_t ro = xrow_off(m0, isc, key); const f32x4* src = (const f32x4*)((isc ? srcC : srcL) + ro) + lane;
#pragma unroll
      for (int j = 0; j < 4; ++j) v[j] = src[64 * j]; }
    if (m0 + 1 < m1) { bool isc; int key; const size_t ro = xrow_off(m0 + 1, isc, key); const f32x4* src = (const f32x4*)((isc ? srcC : srcL) + ro) + lane;
#pragma unroll
      for (int j = 0; j < 4; ++j) vn[j] = src[64 * j]; }
    for (int m = m0; m < m1; ++m) {
        if (m + 2 < m1) { bool isc2; int key2; const size_t ro2 = xrow_off(m + 2, isc2, key2); const f32x4* src2 = (const f32x4*)((isc2 ? srcC : srcL) + ro2) + lane;
#pragma unroll
            for (int j = 0; j < 4; ++j) vnn[j] = src2[64 * j]; }
        bool isc; int key; const size_t roff = xrow_off(m, isc, key);
        if (key != curkey) { curkey = key; const float* md = mod + (size_t)key * 6144 + which * 3 * DM;
#pragma unroll
            for (int j = 0; j < 4; ++j) { const int c = 4 * lane + 256 * j; const f32x4 gg = *(const f32x4*)(g + c), sc = *(const f32x4*)(md + DM + c); shv[j] = *(const f32x4*)(md + c);
#pragma unroll
                for (int e = 0; e < 4; ++e) gm[j][e] = gg[e] * (1.f + sc[e]); } }
        float ss = 0.f;
#pragma unroll
        for (int j = 0; j < 4; ++j) ss += (v[j][0] * v[j][0] + v[j][1] * v[j][1]) + (v[j][2] * v[j][2] + v[j][3] * v[j][3]);
        const float rstd = rsqrtf(wave_sum(ss) * (1.f / DM) + 1e-6f);
        if (cpL) { f32x4* dst = (f32x4*)((isc ? cpC : cpL) + roff) + lane;
#pragma unroll
            for (int j = 0; j < 4; ++j) dst[64 * j] = v[j]; }
#pragma unroll
        for (int j = 0; j < 4; ++j) { const int c = 4 * lane + 256 * j;
            float o[4];
#pragma unroll
            for (int e = 0; e < 4; ++e) o[e] = v[j][e] * rstd * gm[j][e] + shv[j][e];
            u32x2 w; w.x = cvt_pk_bf16(o[0], o[1]); w.y = cvt_pk_bf16(o[2], o[3]);
            *(u32x2*)(H + (size_t)m * DM + c) = w;
            if (HB) { const int tm = m >> 8, rm = m & 255;
                if (rm == 255) *(u32x2*)(HB + (size_t)(2 * tm) * DM + c) = w;
                else if (rm == 0 && tm > 0) *(u32x2*)(HB + (size_t)(2 * (tm - 1) + 1) * DM + c) = w; } }
#pragma unroll
        for (int j = 0; j < 4; ++j) { v[j] = vn[j]; vn[j] = vnn[j]; }
    }
}
__device__ __forceinline__ void phase_final_norm(float* X, const float* g) {
    const int lane = tid_() & 63, wave = tid_() >> 6;
    const int gw = bid_() * NWAVES + wave, NGW = gdim_() * NWAVES;
    const int NR = NB * TL; const int rpw = (NR + NGW - 1) / NGW; const int m0 = gw * rpw, m1 = (m0 + rpw < NR) ? (m0 + rpw) : NR;
    if (m0 >= m1) return;
    f32x4 gg[4], v[4], vn[4];
#pragma unroll
    for (int j = 0; j < 4; ++j) { gg[j] = *(const f32x4*)(g + 4 * lane + 256 * j); v[j] = ((const f32x4*)(X + (size_t)m0 * DM) + lane)[64 * j]; }
    for (int m = m0; m < m1; ++m) {
        if (m + 1 < m1) { const f32x4* s2 = (const f32x4*)(X + (size_t)(m + 1) * DM) + lane;
#pragma unroll
            for (int j = 0; j < 4; ++j) vn[j] = s2[64 * j]; }
        float ss = 0.f;
#pragma unroll
        for (int j = 0; j < 4; ++j) ss += (v[j][0] * v[j][0] + v[j][1] * v[j][1]) + (v[j][2] * v[j][2] + v[j][3] * v[j][3]);
        const float rstd = rsqrtf(wave_sum(ss) * (1.f / DM) + 1e-6f);
        f32x4* dst = (f32x4*)(X + (size_t)m * DM) + lane;
#pragma unroll
        for (int j = 0; j < 4; ++j) { f32x4 o;
#pragma unroll
            for (int e = 0; e < 4; ++e) o[e] = v[j][e] * rstd * gg[j][e];
            dst[64 * j] = o; }
#pragma unroll
        for (int j = 0; j < 4; ++j) v[j] = vn[j];
    }
}
__device__ __forceinline__ void phase_mix(const bf16_t* H, const float* mp, const float* mn, int ma, int mb, bf16_t* OA, bf16_t* OB, const bf16_t* Kt, const float* kk_w, float* KN) {
    const int lane = tid_() & 63, wave = tid_() >> 6;
    const int gw = bid_() * NWAVES + wave, NGW = gdim_() * NWAVES;
    const int rpw = (MR + NGW - 1) / NGW; const int m0 = gw * rpw, m1 = (m0 + rpw < MR) ? (m0 + rpw) : MR;
    if (m0 >= m1) return;
    const int c0 = lane * 16;
    float pa[16], na[16], pb[16], nb[16];
#pragma unroll
    for (int i = 0; i < 16; ++i) { pa[i] = mp[ma * DM + c0 + i]; na[i] = mn[ma * DM + c0 + i]; pb[i] = mp[mb * DM + c0 + i]; nb[i] = mn[mb * DM + c0 + i]; }
    float kw[16];
#pragma unroll
    for (int i = 0; i < 16; ++i) kw[i] = KN ? kk_w[c0 + i] : 0.f;
    const u32x4 z4 = {0u, 0u, 0u, 0u};
    u32x4 P0 = z4, P1 = z4, C0, C1, N0 = z4, N1 = z4, NN0 = z4, NN1 = z4, K0 = z4, K1 = z4, KN0 = z4, KN1 = z4;
    { const u32x4* q = (const u32x4*)(H + (size_t)m0 * DM + c0); C0 = q[0]; C1 = q[1]; }
    if (m0 > 0) { const u32x4* q = (const u32x4*)(H + (size_t)(m0 - 1) * DM + c0); P0 = q[0]; P1 = q[1]; }
    if (m0 + 1 < MR) { const u32x4* q = (const u32x4*)(H + (size_t)(m0 + 1) * DM + c0); N0 = q[0]; N1 = q[1]; }
    if (KN) { const u32x4* kr = (const u32x4*)(Kt + (size_t)m0 * DM + c0); K0 = kr[0]; K1 = kr[1]; }
    for (int m = m0; m < m1; ++m) {
        if (m + 2 < MR && m + 1 < m1) { const u32x4* q = (const u32x4*)(H + (size_t)(m + 2) * DM + c0); NN0 = q[0]; NN1 = q[1]; }
        if (KN && m + 1 < m1) { const u32x4* kr = (const u32x4*)(Kt + (size_t)(m + 1) * DM + c0); KN0 = kr[0]; KN1 = kr[1]; }
        const int b = m / PB, p = m - b * PB;
        const bool first = (p == 0) || (p == TC), lastr = (p == TC - 1) || (p == PB - 1);
        float h[16], hp[16], hn[16];
        unpack8(C0, h); unpack8(C1, h + 8);
        unpack8(first ? z4 : P0, hp); unpack8(first ? z4 : P1, hp + 8);
        unpack8(lastr ? z4 : N0, hn); unpack8(lastr ? z4 : N1, hn + 8);
        float oa[16], ob[16];
#pragma unroll
        for (int i = 0; i < 16; ++i) { const float dp = hp[i] - h[i], dn = hn[i] - h[i];
            oa[i] = h[i] + dp * pa[i] + dn * na[i];
            ob[i] = h[i] + dp * pb[i] + dn * nb[i]; }
        u32x4* da = (u32x4*)(OA + (size_t)m * DM + c0); da[0] = pack8(oa); da[1] = pack8(oa + 8);
        u32x4* db = (u32x4*)(OB + (size_t)m * DM + c0); db[0] = pack8(ob); db[1] = pack8(ob + 8);
        if (KN) {
            float kv[16]; unpack8(K0, kv); unpack8(K1, kv + 8);
            float ss = 0.f;
#pragma unroll
            for (int i = 0; i < 16; ++i) { const float t = kv[i] * kw[i]; ss += t * t; }
            ss = red4(ss);
            if ((lane & 3) == 0) KN[(size_t)m * 16 + (lane >> 2)] = 1.f / fmaxf(sqrtf(ss), 1e-12f);
        }
        P0 = C0; P1 = C1; C0 = N0; C1 = N1; N0 = NN0; N1 = NN1; K0 = KN0; K1 = KN1;
    }
}
__device__ __forceinline__ void phase_convact(const bf16_t* GV, bf16_t* ACT, int rows, int row_off, const float* cw, const float* cb) {
    const size_t nitem = (size_t)rows * 352;
    for (size_t it = (size_t)bid_() * NTHR + tid_(); it < nitem; it += (size_t)gdim_() * NTHR) {
        const int r = (int)(it / 352), cg8 = (int)(it - (size_t)r * 352), n0 = cg8 * 8;
        const int gr = r + row_off; const int b = gr / PB, p = gr - b * PB;
        const bool first = (p == 0) || (p == TC), lastr = (p == TC - 1) || (p == PB - 1);
        const bf16_t* base = GV + (size_t)r * 5632 + n0;
        float g[8], gp[8], gn[8], vv[8];
        unpack8(*(const u32x4*)base, g); unpack8(*(const u32x4*)(base + DFF), vv);
        if (!first) unpack8(*(const u32x4*)(base - 5632), gp); else { for (int i = 0; i < 8; ++i) gp[i] = 0.f; }
        if (!lastr) unpack8(*(const u32x4*)(base + 5632), gn); else { for (int i = 0; i < 8; ++i) gn[i] = 0.f; }
        float o[8];
#pragma unroll
        for (int i = 0; i < 8; ++i) { const float x = gp[i] * cw[n0 + i] + g[i] * cw[DFF + n0 + i] + gn[i] * cw[2 * DFF + n0 + i] + cb[n0 + i];
            o[i] = x / (1.f + __expf(-x)) * vv[i]; }
        *(u32x4*)(ACT + (size_t)r * DFF + n0) = pack8(o);
    }
}
__device__ __forceinline__ void phase_post(const bf16_t* Y0, const bf16_t* Y1, const bf16_t* V, const float* CB, const float* lg, const float* lb, bf16_t* Z) {
    const int lane = tid_() & 63, wave = tid_() >> 6;
    const int gw = bid_() * NWAVES + wave, NGW = gdim_() * NWAVES;
    const int rpw = (MR + NGW - 1) / NGW; const int m0 = gw * rpw, m1 = (m0 + rpw < MR) ? (m0 + rpw) : MR;
    const int c0 = lane * 16, hd = lane >> 2;
    float lgv[16], lbv[16];
#pragma unroll
    for (int i = 0; i < 16; ++i) { lgv[i] = lg[c0 + i]; lbv[i] = lb[c0 + i]; }
    if (m0 >= m1) return;
    u32x4 ya0, ya1, yb0, yb1, vv0, vv1, na0, na1, nb0, nb1, nv0, nv1;
    { const u32x4* q = (const u32x4*)(Y0 + (size_t)m0 * DM + c0); ya0 = q[0]; ya1 = q[1]; q = (const u32x4*)(Y1 + (size_t)m0 * DM + c0); yb0 = q[0]; yb1 = q[1]; q = (const u32x4*)(V + (size_t)m0 * DM + c0); vv0 = q[0]; vv1 = q[1]; }
    na0 = ya0; na1 = ya1; nb0 = yb0; nb1 = yb1; nv0 = vv0; nv1 = vv1;
    for (int m = m0; m < m1; ++m) {
        if (m + 1 < m1) { const u32x4* q = (const u32x4*)(Y0 + (size_t)(m + 1) * DM + c0); na0 = q[0]; na1 = q[1]; q = (const u32x4*)(Y1 + (size_t)(m + 1) * DM + c0); nb0 = q[0]; nb1 = q[1]; q = (const u32x4*)(V + (size_t)(m + 1) * DM + c0); nv0 = q[0]; nv1 = q[1]; }
        float a[16], b2[16], vv[16];
        unpack8(ya0, a); unpack8(ya1, a + 8); unpack8(yb0, b2); unpack8(yb1, b2 + 8); unpack8(vv0, vv); unpack8(vv1, vv + 8);
        ya0 = na0; ya1 = na1; yb0 = nb0; yb1 = nb1; vv0 = nv0; vv1 = nv1;
        float s = 0.f;
#pragma unroll
        for (int i = 0; i < 16; ++i) { a[i] += b2[i]; s += a[i]; }
        s = red4(s); const float mu = s * (1.f / 64.f); float q2 = 0.f;
#pragma unroll
        for (int i = 0; i < 16; ++i) { a[i] -= mu; q2 += a[i] * a[i]; }
        q2 = red4(q2); const float rs = rsqrtf(q2 * (1.f / 64.f) + 64e-5f);
        const float bon = CB[(size_t)m * 16 + hd] + CB[(size_t)MR * 16 + (size_t)m * 16 + hd];
        float o[16];
#pragma unroll
        for (int i = 0; i < 16; ++i) o[i] = a[i] * rs * lgv[i] + lbv[i] + bon * vv[i];
        u32x4* d = (u32x4*)(Z + (size_t)m * DM + c0); d[0] = pack8(o); d[1] = pack8(o + 8);
    }
}

namespace att {
constexpr int KVBLK = 64, LD = 1024;
constexpr float SCALE = 0.125f;
constexpr float THR = 8.f;
constexpr size_t SHM_V = KVBLK * 128 * 2, SHM_K = KVBLK * 128 * 2;
#define KSWZ(row, colB) ((row) * 256 + ((colB) ^ (((row) & 7) << 4)))
#define SBAR() __builtin_amdgcn_sched_barrier(0)
__device__ __forceinline__ int crow(int r, int hi) { return (r & 3) + 8 * (r >> 2) + 4 * hi; }
__device__ __forceinline__ void partialSM(f32x16& p0, f32x16& p1, float& m_reg, float& mn, float& alpha) {
    constexpr float C = SCALE * 1.4426950408889634f;
    float pmax = p0[0];
#pragma unroll
    for (int r = 1; r < 16; ++r) pmax = fmaxf(pmax, p0[r]);
#pragma unroll
    for (int r = 0; r < 16; ++r) pmax = fmaxf(pmax, p1[r]);
    { auto rr = __builtin_amdgcn_permlane32_swap(__float_as_uint(pmax), __float_as_uint(pmax), false, false);
      pmax = fmaxf(__uint_as_float(rr[0]), __uint_as_float(rr[1])); }
    if (__builtin_expect(__all(pmax - m_reg <= THR / SCALE), 1)) { mn = m_reg; alpha = 1.f; }
    else { mn = fmaxf(m_reg, pmax); alpha = __builtin_amdgcn_exp2f((m_reg - mn) * C); m_reg = mn; }
    const float mnC = -mn * C;
#pragma unroll
    for (int r = 0; r < 16; ++r) p0[r] = fmaf(p0[r], C, mnC);
#pragma unroll
    for (int r = 0; r < 16; ++r) p1[r] = fmaf(p1[r], C, mnC);
#pragma unroll
    for (int r = 0; r < 16; ++r) p0[r] = __builtin_amdgcn_exp2f(p0[r]);
}
__device__ __forceinline__ void finishSM(f32x16& p0, f32x16& p1, float alpha, float& l_reg, bf16x8& pa0, bf16x8& pa1, bf16x8& pa2, bf16x8& pa3) {
#pragma unroll
    for (int r = 0; r < 16; ++r) p1[r] = __builtin_amdgcn_exp2f(p1[r]);
    float ps = 0;
#pragma unroll
    for (int r = 0; r < 16; ++r) ps += p0[r];
#pragma unroll
    for (int r = 0; r < 16; ++r) ps += p1[r];
    { auto rr = __builtin_amdgcn_permlane32_swap(__float_as_uint(ps), __float_as_uint(ps), false, false);
      ps = __uint_as_float(rr[0]) + __uint_as_float(rr[1]); }
    l_reg = l_reg * alpha + ps;
#define PK4(P, BASE, OUT) do { unsigned a0 = cvt_pk_bf16(P[BASE + 0], P[BASE + 1]), a1 = cvt_pk_bf16(P[BASE + 2], P[BASE + 3]);   \
    unsigned b0 = cvt_pk_bf16(P[BASE + 4], P[BASE + 5]), b1 = cvt_pk_bf16(P[BASE + 6], P[BASE + 7]);                              \
    auto r0 = __builtin_amdgcn_permlane32_swap(a0, b0, false, false); auto r1 = __builtin_amdgcn_permlane32_swap(a1, b1, false, false); \
    u32x4 w = {r0[0], r1[0], r0[1], r1[1]}; OUT = *reinterpret_cast<bf16x8*>(&w); } while (0)
    PK4(p0, 0, pa0); PK4(p0, 8, pa1); PK4(p1, 0, pa2); PK4(p1, 8, pa3);
#undef PK4
}
__device__ __forceinline__ void qkt(f32x16& p0, f32x16& p1, const char* Ks, const bf16x8* qr, int r32, int hi, int comp) {
    p0 = f32x16{}; p1 = f32x16{};
#pragma unroll
    for (int d0 = 0; d0 < 4; ++d0) { const int cb = (comp * 64 + d0 * 16 + hi * 8) * 2;
        const bf16x8 b0 = *reinterpret_cast<const bf16x8*>(Ks + KSWZ(r32, cb));
        const bf16x8 b1 = *reinterpret_cast<const bf16x8*>(Ks + KSWZ(32 + r32, cb));
        p0 = __builtin_amdgcn_mfma_f32_32x32x16_bf16(b0, qr[d0], p0, 0, 0, 0);
        p1 = __builtin_amdgcn_mfma_f32_32x32x16_bf16(b1, qr[d0], p1, 0, 0, 0); }
}
__device__ __forceinline__ int v_st(int k, int c) { const int kk = (k & ~0xC) | ((k & 4) << 1) | ((k & 8) >> 1); return ((kk >> 3) * 4 + (c >> 5)) * 512 + ((kk & 7) * 32 + (c & 31)) * 2; }
__device__ __forceinline__ int v_rd_base(int lane) { return ((lane & 3) << 3) | (((lane >> 2) & 3) << 6) | (((lane >> 4) & 1) << 5) | (((lane >> 5) & 1) << 8); }
constexpr int v_rd_off(int d0, int ks, int half) { return d0 * 512 + ks * 4096 + half * 2048; }
template <int OFF> __device__ __forceinline__ s16x4 tr_read(int vb) {
    s16x4 r; asm volatile("ds_read_b64_tr_b16 %0, %1 offset:%2" : "=&v"(r) : "v"(vb), "i"(OFF) : "memory"); return r;
}
template <int D0> __device__ __forceinline__ void pv_one(f32x16& od, int vb, bf16x8 pa0, bf16x8 pa1, bf16x8 pa2, bf16x8 pa3) {
    const s16x4 l0 = tr_read<v_rd_off(D0, 0, 0)>(vb), h0 = tr_read<v_rd_off(D0, 0, 1)>(vb), l1 = tr_read<v_rd_off(D0, 1, 0)>(vb), h1 = tr_read<v_rd_off(D0, 1, 1)>(vb);
    const s16x4 l2 = tr_read<v_rd_off(D0, 2, 0)>(vb), h2 = tr_read<v_rd_off(D0, 2, 1)>(vb), l3 = tr_read<v_rd_off(D0, 3, 0)>(vb), h3 = tr_read<v_rd_off(D0, 3, 1)>(vb);
    asm volatile("s_waitcnt lgkmcnt(0)" ::: "memory"); SBAR();
#define PK(L, H) (bf16x8){L[0], L[1], L[2], L[3], H[0], H[1], H[2], H[3]}
    od = __builtin_amdgcn_mfma_f32_32x32x16_bf16(pa0, PK(l0, h0), od, 0, 0, 0);
    od = __builtin_amdgcn_mfma_f32_32x32x16_bf16(pa1, PK(l1, h1), od, 0, 0, 0);
    od = __builtin_amdgcn_mfma_f32_32x32x16_bf16(pa2, PK(l2, h2), od, 0, 0, 0);
    od = __builtin_amdgcn_mfma_f32_32x32x16_bf16(pa3, PK(l3, h3), od, 0, 0, 0);
#undef PK
}
__device__ __forceinline__ void pv_d0(f32x16* o, int vb, bf16x8 pa0, bf16x8 pa1, bf16x8 pa2, bf16x8 pa3) {
    pv_one<0>(o[0], vb, pa0, pa1, pa2, pa3); pv_one<1>(o[1], vb, pa0, pa1, pa2, pa3); pv_one<2>(o[2], vb, pa0, pa1, pa2, pa3); pv_one<3>(o[3], vb, pa0, pa1, pa2, pa3);
}
__device__ __forceinline__ void attn_unit(const bf16_t* Qb, const bf16_t* Kh, const bf16_t* Vh, bf16_t* Ob, float* scr, int seq, float lam, float onemli, const float* subg, char* lds) {
    const int tid = tid_(), wid = tid >> 6, lane = tid & 63, r32 = lane & 31, hi = lane >> 5;
    char* V_lds = lds; char* K_lds = lds + 2 * SHM_V;
    float* wsl = (float*)(lds + 2 * SHM_V + 2 * SHM_K) + wid * 64; float* li_l = wsl; float* al_l = wsl + 32;
    const int sr = tid >> 4, sc = (tid & 15) * 8, vst0 = v_st(sr, sc), vst1 = v_st(32 + sr, sc);
    const unsigned kvoff = (unsigned)(sr * LD + sc) * 2u;
    const int vb0 = (int)(uintptr_t)V_lds + v_rd_base(lane);
    const int NT = seq / KVBLK;
#pragma unroll
    for (int comp = 0; comp < 2; ++comp) {
        float m_reg = -1e30f, l_reg = 0; f32x16 o[4] = {}; bf16x8 qr[4];
        const unsigned qoff = (unsigned)((wid * 32 + r32) * LD + comp * 64 + hi * 8) * 2u;
#pragma unroll
        for (int d0 = 0; d0 < 4; ++d0) qr[d0] = *reinterpret_cast<const bf16x8*>((const char*)Qb + qoff + d0 * 32);
        struct { bf16x8 vs0, vs1, ks0, ks1; } sr_[1];
#define SLOAD(i, k0) do { const unsigned o0_ = kvoff + (unsigned)(k0) * (LD * 2), o1_ = o0_ + 32 * LD * 2; \
    sr_[i].vs0 = *reinterpret_cast<const bf16x8*>((const char*)Vh + o0_); sr_[i].vs1 = *reinterpret_cast<const bf16x8*>((const char*)Vh + o1_); \
    sr_[i].ks0 = *reinterpret_cast<const bf16x8*>((const char*)Kh + o0_); sr_[i].ks1 = *reinterpret_cast<const bf16x8*>((const char*)Kh + o1_); } while (0)
#define SWRITE(b, i) do { *(bf16x8*)(V_lds + (b) * SHM_V + vst0) = sr_[i].vs0;          \
    *(bf16x8*)(V_lds + (b) * SHM_V + vst1) = sr_[i].vs1; int kc = sc * 2;               \
    *(bf16x8*)(K_lds + (b) * SHM_K + KSWZ(sr, kc)) = sr_[i].ks0;                       \
    *(bf16x8*)(K_lds + (b) * SHM_K + KSWZ(32 + sr, kc)) = sr_[i].ks1; } while (0)
#define SWAIT() asm volatile("s_waitcnt vmcnt(0)" ::: "memory")
#define RESC(a) do { if (__any((a) < 1.f)) { if (hi == 0) al_l[r32] = (a); asm volatile("s_waitcnt lgkmcnt(0)" ::: "memory"); \
    _Pragma("unroll") for (int d = 0; d < 4; ++d) _Pragma("unroll") for (int r = 0; r < 16; ++r) o[d][r] *= al_l[crow(r, hi)]; } } while (0)
        f32x16 pA0, pA1, pB0, pB1; float mnA, mnB, alA, alB; bf16x8 pa0, pa1, pa2, pa3;
        constexpr int SE = 0, SO = 0;
        __syncthreads();
        SLOAD(SE, 0); asm volatile("s_waitcnt vmcnt(0)" ::: "memory"); SWRITE(0, SE); __syncthreads();
        qkt(pA0, pA1, K_lds, qr, r32, hi, comp); partialSM(pA0, pA1, m_reg, mnA, alA);
        SLOAD(SO, KVBLK);
        SWAIT(); SWRITE(1, SO); __syncthreads();
        for (int j = 1; j + 1 < NT; j += 2) {
            SBAR(); qkt(pB0, pB1, K_lds + SHM_K, qr, r32, hi, comp);
            finishSM(pA0, pA1, alA, l_reg, pa0, pa1, pa2, pa3); SBAR();
            SLOAD(SO, (j + 1) * KVBLK); SBAR();
            pv_d0(o, vb0, pa0, pa1, pa2, pa3); partialSM(pB0, pB1, m_reg, mnB, alB);
            __syncthreads(); SWAIT(); SWRITE(0, SE);
            RESC(alB); __syncthreads();
            SBAR(); qkt(pA0, pA1, K_lds, qr, r32, hi, comp);
            finishSM(pB0, pB1, alB, l_reg, pa0, pa1, pa2, pa3); SBAR();
            SLOAD(SE, (j + 2) * KVBLK); SBAR();
            pv_d0(o, vb0 + (int)SHM_V, pa0, pa1, pa2, pa3); partialSM(pA0, pA1, m_reg, mnA, alA);
            __syncthreads(); SWAIT(); SWRITE(1, SO);
            RESC(alA); __syncthreads();
        }
        SBAR(); qkt(pB0, pB1, K_lds + SHM_K, qr, r32, hi, comp);
        finishSM(pA0, pA1, alA, l_reg, pa0, pa1, pa2, pa3); SBAR();
        pv_d0(o, vb0, pa0, pa1, pa2, pa3); partialSM(pB0, pB1, m_reg, mnB, alB);
        __syncthreads(); RESC(alB);
        finishSM(pB0, pB1, alB, l_reg, pa0, pa1, pa2, pa3); SBAR();
        pv_d0(o, vb0 + (int)SHM_V, pa0, pa1, pa2, pa3);
        if (hi == 0) li_l[r32] = l_reg; asm volatile("s_waitcnt lgkmcnt(0)" ::: "memory");
        float rli[16];
#pragma unroll
        for (int r = 0; r < 16; ++r) rli[r] = __builtin_amdgcn_rcpf(li_l[crow(r, hi)]);
        unsigned soff = (unsigned)((wid * 64 + lane) * 256); asm volatile("" : "+v"(soff));
        f32x4* sw = (f32x4*)((char*)scr + soff);
        if (comp == 0) {
#pragma unroll
            for (int d0 = 0; d0 < 4; ++d0)
#pragma unroll
                for (int r = 0; r < 16; r += 4) sw[d0 * 4 + (r >> 2)] = (f32x4){o[d0][r] * rli[r], o[d0][r + 1] * rli[r + 1], o[d0][r + 2] * rli[r + 2], o[d0][r + 3] * rli[r + 3]};
        } else {
            float ssq[16];
#pragma unroll
            for (int r = 0; r < 16; ++r) ssq[r] = 0.f;
#pragma unroll
            for (int d0 = 0; d0 < 4; ++d0) {
#pragma unroll
                for (int r4 = 0; r4 < 4; ++r4) { const f32x4 pv = sw[d0 * 4 + r4];
#pragma unroll
                    for (int e = 0; e < 4; ++e) { const int r = r4 * 4 + e; const float x = pv[e] - lam * (o[d0][r] * rli[r]); o[d0][r] = x; ssq[r] += x * x; } }
                asm volatile("" ::: "memory");
            }
#pragma unroll
            for (int r = 0; r < 16; ++r) {
                float s = ssq[r];
                s += __shfl_xor(s, 1); s += __shfl_xor(s, 2); s += __shfl_xor(s, 4); s += __shfl_xor(s, 8); s += __shfl_xor(s, 16);
                ssq[r] = rsqrtf(s * (1.f / 128.f) + 1e-6f) * onemli;
            }
            float sg[4];
#pragma unroll
            for (int d0 = 0; d0 < 4; ++d0) sg[d0] = subg[d0 * 32 + r32];
            char* stg = lds + 67584 + wid * 8704;
            unsigned sbase = (unsigned)((4 * hi) * 272 + r32 * 2); asm volatile("" : "+v"(sbase));
#pragma unroll
            for (int r = 0; r < 16; ++r) { const int orow = (r & 3) + 8 * (r >> 2);
#pragma unroll
                for (int d0 = 0; d0 < 4; ++d0) { const unsigned w = cvt_pk_bf16(o[d0][r] * ssq[r] * sg[d0], 0.f); *(bf16_t*)(stg + sbase + orow * 272 + d0 * 64) = (bf16_t)(w & 0xffffu); } }
            asm volatile("s_waitcnt lgkmcnt(0)" ::: "memory");
            unsigned rdo = (unsigned)((lane >> 4) * 272 + (lane & 15) * 16); asm volatile("" : "+v"(rdo));
            unsigned gwo = (unsigned)(((wid * 32 + (lane >> 4)) * LD + (lane & 15) * 8) * 2); asm volatile("" : "+v"(gwo));
#pragma unroll
            for (int it = 0; it < 8; ++it) { const u32x4 w = *(const u32x4*)(stg + rdo + it * 4 * 272); *(u32x4*)((char*)Ob + gwo + it * 4 * LD * 2) = w; }
            asm volatile("s_waitcnt lgkmcnt(0)" ::: "memory");
        }
#undef SLOAD
#undef SWRITE
#undef SWAIT
#undef RESC
    }
}
}

__device__ __forceinline__ void phase_attn(const bf16_t* Q, const bf16_t* K, const bf16_t* V, bf16_t* O, float* scr_all, const float* lamv, float lambda_init, const float* subg, char* lds) {
    float s01 = 0.f, s23 = 0.f;
    for (int i = 0; i < 64; ++i) { s01 += lamv[i] * lamv[64 + i]; s23 += lamv[128 + i] * lamv[192 + i]; }
    const float lam = __expf(s01) - __expf(s23) + lambda_init;
    const float onemli = 1.f - lambda_init;
    float* scr = scr_all + (size_t)bid_() * 32768;
    const int G = gdim_(), blk = bid_();
    const int NU = NB * 8 * 16 + NB * 8;
    for (int i = 0;; ++i) {
        int u = i * G + blk; if (u >= NU) break;
        int pair, qb; bool isctx = false;
        if (u < 2048) {
            if (G == 256) { const int x = blk & 7, vb = blk >> 3; pair = i * 16 + 2 * x + (vb >> 4); qb = vb & 15; }
            else { pair = u >> 4; qb = u & 15; }
        } else { pair = u - 2048; qb = 0; isctx = true; }
        const int b = pair >> 3, h = pair & 7;
        const size_t rb = (size_t)b * PB;
        const size_t qrow = rb + (isctx ? 0 : (TC + qb * 256));
        att::attn_unit(Q + qrow * DM + h * 128, K + rb * DM + h * 128, V + rb * DM + h * 128, O + qrow * DM + h * 128, scr, isctx ? TC : PB, lam, onemli, subg, lds);
    }
}

struct ScanArgs { const bf16_t *R, *K, *V, *WL, *AL; const float* KN; const bf16_t *W2T, *A2T; const float *w0, *a0, *k_k, *k_a, *r_k; bf16_t *Y0, *Y1; float* CB; };
__device__ __forceinline__ int scan_row(int dir, int s) { return dir == 0 ? s : (s < TC ? (TC - 1 - s) : (PB + TC - 1 - s)); }

struct ScanRaw { bf16x8 aw[2], aa[2]; unsigned kv[2][4], rv[2][4], vv[2][4]; float knv[4]; };
__device__ __forceinline__ void scan_issue(const ScanArgs& A, int dir, int b, int h, int nbh, int chunk, int lane, ScanRaw& R) {
    const int kq = lane >> 4, l16 = lane & 15;
    const int s0 = chunk * 16;
    const size_t mA = (size_t)b * PB + scan_row(dir, s0 + l16);
#pragma unroll
    for (int ks = 0; ks < 2; ++ks) { R.aw[ks] = *(const bf16x8*)(A.WL + mA * 128 + dir * 64 + ks * 32 + kq * 8); R.aa[ks] = *(const bf16x8*)(A.AL + mA * 128 + dir * 64 + ks * 32 + kq * 8); }
#pragma unroll
    for (int i = 0; i < 4; ++i) { const unsigned mrow = (unsigned)(b * PB + scan_row(dir, s0 + kq * 4 + i)); R.knv[i] = A.KN[(size_t)mrow * 16 + h];
#pragma unroll
        for (int nb2 = 0; nb2 < 2; ++nb2) { const int n = (nbh * 2 + nb2) * 16 + l16; const unsigned g = (mrow * DM + h * 64 + n) * 2u;
            R.kv[nb2][i] = *(const bf16_t*)((const char*)A.K + g); R.rv[nb2][i] = *(const bf16_t*)((const char*)A.R + g); R.vv[nb2][i] = *(const bf16_t*)((const char*)A.V + g); } }
}
__device__ __forceinline__ void scan_process(const ScanRaw& R, int nbh, LAS float* IN, LAS float* BON, int lane,
                                             const bf16x8 (&w2b)[2][2], const bf16x8 (&a2b)[2][2], const float (&w0v)[2], const float (&a0v)[2], const float (&kkv)[2], const float (&kav)[2], const float (&rkv)[2]) {
    const int kq = lane >> 4, l16 = lane & 15;
    float bon[4] = {0.f, 0.f, 0.f, 0.f};
#pragma unroll
    for (int nb2 = 0; nb2 < 2; ++nb2) {
        const int nb = nbh * 2 + nb2; const int n = nb * 16 + l16;
        f32x4 accw = {0.f, 0.f, 0.f, 0.f}, acca = {0.f, 0.f, 0.f, 0.f};
        accw = __builtin_amdgcn_mfma_f32_16x16x32_bf16(R.aw[0], w2b[0][nb2], accw, 0, 0, 0);
        accw = __builtin_amdgcn_mfma_f32_16x16x32_bf16(R.aw[1], w2b[1][nb2], accw, 0, 0, 0);
        acca = __builtin_amdgcn_mfma_f32_16x16x32_bf16(R.aa[0], a2b[0][nb2], acca, 0, 0, 0);
        acca = __builtin_amdgcn_mfma_f32_16x16x32_bf16(R.aa[1], a2b[1][nb2], acca, 0, 0, 0);
#pragma unroll
        for (int i = 0; i < 4; ++i) {
            const int tp = kq * 4 + i;
            const float kv = __uint_as_float(R.kv[nb2][i] << 16), rv = __uint_as_float(R.rv[nb2][i] << 16), vv = __uint_as_float(R.vv[nb2][i] << 16);
            const float win = w0v[nb2] + accw[i];
            const float decay = __expf(-0.6065306597126334f * sigmoidf_(win));
            const float a = sigmoidf_(a0v[nb2] + acca[i]);
            const float kk = kv * kkv[nb2] * R.knv[i];
            const float kd = kv * (1.f + (a - 1.f) * kav[nb2]);
            bon[i] += rv * kd * rkv[nb2];
            LAS float* d = IN + tp * 64 + n;
            d[0 * 1024] = decay; d[1 * 1024] = kd; d[2 * 1024] = kk * a; d[3 * 1024] = -kk; d[4 * 1024] = rv; d[5 * 1024] = vv;
        }
    }
#pragma unroll
    for (int i = 0; i < 4; ++i) { const float s = red16(bon[i]); if (l16 == 0) BON[nbh * 16 + kq * 4 + i] = s; }
}

__device__ __forceinline__ void phase_scan(const ScanArgs A, LAS unsigned char* lds) {
    const int tid = tid_(), lane = tid & 63, wave = __builtin_amdgcn_readfirstlane(tid >> 6);
    constexpr int NCH = PB / 16;
    for (int cp = bid_(); cp < 256; cp += gdim_()) {
        const int dir = cp >> 7, rem = cp & 127, b = rem >> 3, h0 = (rem & 7) * 2;
        const bool consumer = wave < 4;
        const int chain = consumer ? (wave >> 1) : ((wave - 4) >> 1);
        const int half = wave & 1;
        const int h = h0 + chain;
        LAS float* INc = (LAS float*)(lds + chain * 49152);
        LAS float* YBc = (LAS float*)(lds + 98304 + chain * 8192);
        LAS float* BONc = (LAS float*)(lds + 114688 + chain * 512);
        bf16_t* Yd = dir == 0 ? A.Y0 : A.Y1;
        bf16x8 w2b[2][2], a2b[2][2]; float w0v[2], a0v[2], kkv[2], kav[2], rkv[2];
        if (!consumer) {
            const int kq = lane >> 4, l16 = lane & 15;
#pragma unroll
            for (int nb2 = 0; nb2 < 2; ++nb2) { const int n = h * 64 + (half * 2 + nb2) * 16 + l16;
#pragma unroll
                for (int ks = 0; ks < 2; ++ks) { w2b[ks][nb2] = *(const bf16x8*)(A.W2T + ((size_t)dir * DM + n) * 64 + ks * 32 + kq * 8); a2b[ks][nb2] = *(const bf16x8*)(A.A2T + ((size_t)dir * DM + n) * 64 + ks * 32 + kq * 8); }
                w0v[nb2] = A.w0[dir * DM + n]; a0v[nb2] = A.a0[dir * DM + n]; kkv[nb2] = A.k_k[n]; kav[nb2] = A.k_a[n]; rkv[nb2] = A.r_k[n]; }
        }
        f32x2 S2[2][8];
#pragma unroll
        for (int i = 0; i < 2; ++i)
#pragma unroll
            for (int p = 0; p < 8; ++p) S2[i][p] = (f32x2){0.f, 0.f};
        const int rb = lane >> 2, kq = lane & 3;
        __syncthreads();
        ScanRaw RW_;
        if (!consumer) { scan_issue(A, dir, b, h, half, 0, lane, RW_); scan_process(RW_, half, INc, BONc, lane, w2b, a2b, w0v, a0v, kkv, kav, rkv); scan_issue(A, dir, b, h, half, 1, lane, RW_); }
        __syncthreads();
        for (int c = 0; c < NCH; ++c) {
            if (consumer) {
                const LAS float* in = INc + (c & 1) * 6144;
                LAS float* yb = YBc + (c & 1) * 1024;
#pragma unroll 2
                for (int t = 0; t < 16; ++t) {
                    const LAS float* q = in + t * 64 + kq * 16;
                    f32x4 Wv[4], KDv[4], Bv[4], ANv[4], Rv[4];
#pragma unroll
                    for (int j = 0; j < 4; ++j) { Wv[j] = *(const LAS f32x4*)(q + 4 * j); KDv[j] = *(const LAS f32x4*)(q + 1024 + 4 * j); Bv[j] = *(const LAS f32x4*)(q + 2048 + 4 * j);
                                                  ANv[j] = *(const LAS f32x4*)(q + 3072 + 4 * j); Rv[j] = *(const LAS f32x4*)(q + 4096 + 4 * j); }
                    const f32x2 v2 = *(const LAS f32x2*)(in + 5120 + t * 64 + half * 32 + rb * 2);
#define PAIR(V, p) ((f32x2){V[(p) >> 1][((p) & 1) * 2], V[(p) >> 1][((p) & 1) * 2 + 1]})
                    float sa[2], y[2];
#pragma unroll
                    for (int i = 0; i < 2; ++i) { f32x2 a0 = {0.f, 0.f}, a1 = {0.f, 0.f};
#pragma unroll
                        for (int p = 0; p < 8; p += 2) { a0 += S2[i][p] * PAIR(ANv, p); a1 += S2[i][p + 1] * PAIR(ANv, p + 1); }
                        a0 += a1; sa[i] = red4(a0[0] + a0[1]); }
#pragma unroll
                    for (int i = 0; i < 2; ++i) { f32x2 y0 = {0.f, 0.f}, y1 = {0.f, 0.f}; const f32x2 sai = {sa[i], sa[i]}, vi = {v2[i], v2[i]};
#pragma unroll
                        for (int p = 0; p < 8; p += 2) {
                            const f32x2 n0 = S2[i][p] * PAIR(Wv, p) + sai * PAIR(Bv, p) + vi * PAIR(KDv, p);
                            const f32x2 n1 = S2[i][p + 1] * PAIR(Wv, p + 1) + sai * PAIR(Bv, p + 1) + vi * PAIR(KDv, p + 1);
                            S2[i][p] = n0; S2[i][p + 1] = n1; y0 += n0 * PAIR(Rv, p); y1 += n1 * PAIR(Rv, p + 1); }
                        y0 += y1; y[i] = red4(y0[0] + y0[1]); }
#undef PAIR
                    if (kq == 0) *(LAS f32x2*)(yb + t * 64 + half * 32 + rb * 2) = (f32x2){y[0], y[1]};
                }
            } else {
                if (half == 0 && lane < 16) {
                    const LAS float* bo = BONc + (c & 1) * 32;
                    const size_t m = (size_t)b * PB + scan_row(dir, c * 16 + lane);
                    A.CB[(size_t)dir * MR * 16 + m * 16 + h] = bo[lane] + bo[16 + lane];
                }
                if (c >= 1) {
                    const int t = half * 8 + (lane >> 3), c8 = (lane & 7) * 8;
                    const LAS float* yb = YBc + ((c - 1) & 1) * 1024 + t * 64 + c8;
                    float f[8];
#pragma unroll
                    for (int i = 0; i < 8; ++i) f[i] = yb[i];
                    const size_t m = (size_t)b * PB + scan_row(dir, (c - 1) * 16 + t);
                    *(u32x4*)(Yd + m * DM + h * 64 + c8) = pack8(f);
                }
                if (c + 1 < NCH) { scan_process(RW_, half, INc + ((c + 1) & 1) * 6144, BONc + ((c + 1) & 1) * 32, lane, w2b, a2b, w0v, a0v, kkv, kav, rkv);
                                   if (c + 2 < NCH) scan_issue(A, dir, b, h, half, c + 2, lane, RW_); }
            }
            __syncthreads();
        }
        if (!consumer) {
            const int c = NCH;
            const int t = half * 8 + (lane >> 3), c8 = (lane & 7) * 8;
            const LAS float* yb = YBc + ((c - 1) & 1) * 1024 + t * 64 + c8;
            float f[8];
#pragma unroll
            for (int i = 0; i < 8; ++i) f[i] = yb[i];
            const size_t m = (size_t)b * PB + scan_row(dir, (c - 1) * 16 + t);
            *(u32x4*)(Yd + m * DM + h * 64 + c8) = pack8(f);
        }
        __syncthreads();
    }
}

enum { ST_NOP = 0, ST_P0, ST_NORM, ST_GEMM, ST_ATTN, ST_MIX, ST_SCAN, ST_POST, ST_CONV, ST_FINAL };
struct Step {
    int type, sync;
    pg8::Gemm g; EpiGen e;
    int i0, i1, i2;
    bf16_t* Vb;
};
constexpr int NSTEPS = 1 + 2 * 8 + 2 * 20 + 1;

__host__ __device__ __forceinline__ void make_step(int st, const Params& P, unsigned char* ws, Step& S) {
    const float* MOD = (const float*)(ws + WS_MOD);
    bf16_t* A0 = (bf16_t*)(ws + WS_A0); bf16_t* A1 = (bf16_t*)(ws + WS_A1); bf16_t* A2 = (bf16_t*)(ws + WS_A2); bf16_t* A3 = (bf16_t*)(ws + WS_A3); bf16_t* A4 = (bf16_t*)(ws + WS_A4);
    bf16_t* VF = (bf16_t*)(ws + WS_VF);
    bf16_t* WLb = (bf16_t*)(ws + WS_LORA); bf16_t* ALb = (bf16_t*)(ws + WS_LORA + LORA_SZ); bf16_t* GLb = (bf16_t*)(ws + WS_LORA + 2 * LORA_SZ); bf16_t* VLb = (bf16_t*)(ws + WS_LORA + 3 * LORA_SZ);
    const unsigned char* WB = ws + WS_W;
    S.type = ST_NOP; S.sync = 0; S.i0 = S.i1 = S.i2 = 0; S.Vb = nullptr;
    S.g = pg8::Gemm{nullptr, nullptr, MR, DM, DM, DM, DM, 0, 0};
    S.e = EpiGen{EM_BF16, nullptr, nullptr, nullptr, nullptr, nullptr, nullptr, P.out, (float*)(ws + WS_CTXR), DM, DM, 0, 0, 0, 0u};
    if (st == 0) { S.type = ST_P0; S.sync = 1; return; }
    if (st == NSTEPS - 1) { S.type = ST_FINAL; return; }
    int r = st - 1, layer = 0;
    for (;; ++layer) { const int len = (layer & 1) ? 20 : 8; if (r < len) break; r -= len; }
    const int j = layer >> 1; const bool rw = layer & 1; const int lastl = (layer == NLAYER - 1) ? 1 : 0;
    const float* mod = MOD + (size_t)layer * 17 * 6144;
    const int nmix = rw ? 16 : 4;
    if (r == 0) { S.type = ST_NORM; S.sync = 1; S.i0 = layer; S.i1 = 0; S.i2 = (layer == 0); return; }
    if (r >= nmix) {
        const int f = r - nmix;
        if (f == 0) { S.type = ST_NORM; S.sync = 1; S.i0 = layer; S.i1 = 1; S.i2 = 0; return; }
        bf16_t* HALO = A4; bf16_t* HB = (bf16_t*)(ws + WS_A4 + 16 * MiB);
        if (f == 1) { S.type = ST_GEMM; S.sync = 1; S.g = pg8::Gemm{HB, (const bf16_t*)(WB + W_UP2(layer)), 768, 2 * DFF, DM, DM, DM, 0, 0}; S.e.mode = EM_BF16; S.e.O = HALO; S.e.ldc = 2 * DFF; S.e.nstore = 2 * DFF; S.e.act = 0; }
        else if (f == 2) { S.type = ST_GEMM; S.sync = 1; S.g = pg8::Gemm{A0, (const bf16_t*)(WB + W_UP2(layer)), lastl ? NB * TL : MR, 2 * DFF, DM, DM, DM, 0, lastl}; S.e.mode = EM_GLU; S.e.O = A1; S.e.VFp = HALO;
                      S.e.f0 = P.in[9] + (size_t)layer * 3 * DFF; S.e.f1 = P.in[10] + (size_t)layer * DFF; }
        else { S.type = ST_GEMM; S.sync = 1; S.g = pg8::Gemm{A1, (const bf16_t*)(WB + W_DN2(layer)), lastl ? NB * TL : MR, DM, DFF, DFF, DFF, 0, lastl}; S.e.mode = EM_RES; S.e.f0 = mod; S.e.k = 5; S.e.row_off = 0; }
        return;
    }
    if (!rw) {
        if (r == 1) { S.type = ST_GEMM; S.sync = 1; S.g = pg8::Gemm{A0, (const bf16_t*)(WB + W_QKV(j)), MR, 3072, DM, DM, DM, 0, 0}; S.e.mode = EM_QKV; S.e.O = A1; S.e.O2 = A2; S.e.O3 = A3; S.e.f0 = (const float*)(ws + WS_ROPE); }
        else if (r == 2) { S.type = ST_ATTN; S.sync = 1; S.i0 = j; S.i1 = layer; }
        else { S.type = ST_GEMM; S.sync = 1; S.g = pg8::Gemm{A0, (const bf16_t*)(WB + W_AO(j)), MR, DM, DM, DM, DM, 0, 0}; S.e.mode = EM_RES; S.e.f0 = mod; S.e.k = 2; S.e.row_off = 0; }
        return;
    }
    const unsigned char* RW = WB + W_RWB(j);
    bf16_t* Vb = (j == 0) ? VF : A3; S.Vb = Vb;
    switch (r) {
    case 1: S.type = ST_MIX; S.sync = 1; S.i0 = 2; S.i1 = 3; S.i2 = j; break;
    case 2: S.type = ST_GEMM; S.g = pg8::Gemm{A1, (const bf16_t*)(RW + RW_K), MR, DM, DM, DM, DM, 0, 0}; S.e.O = A4; break;
    case 3: S.type = ST_GEMM; S.g = pg8::Gemm{A2, (const bf16_t*)(RW + RW_V), MR, DM, DM, DM, DM, 192, 0}; S.e.O = Vb; break;
    case 4: S.sync = 1; if (j > 0) { S.type = ST_GEMM; S.g = pg8::Gemm{A2, (const bf16_t*)(RW + RW_V1), MR, 256, DM, DM, DM, 128, 0}; S.e.O = VLb; S.e.ldc = 128; S.e.nstore = 128; } break;
    case 5: S.type = ST_MIX; S.sync = 1; S.i0 = 1; S.i1 = 4; S.i2 = j | 256; break;
    case 6: S.type = ST_GEMM; S.g = pg8::Gemm{A1, (const bf16_t*)(RW + RW_W1), MR, 256, DM, DM, DM, 0, 0}; S.e.O = WLb; S.e.ldc = 128; S.e.nstore = 128; S.e.act = 1; break;
    case 7: S.type = ST_GEMM; S.g = pg8::Gemm{A2, (const bf16_t*)(RW + RW_A1), MR, 256, DM, DM, DM, 240, 0}; S.e.O = ALb; S.e.ldc = 128; S.e.nstore = 128; break;
    case 8: S.sync = 1; if (j > 0) { S.type = ST_GEMM; S.g = pg8::Gemm{VLb, (const bf16_t*)(RW + RW_V2), MR, DM, 128, 128, 128, 224, 0}; S.e.mode = EM_VMIX; S.e.O = Vb; S.e.VFp = VF; S.e.f0 = P.in[27] + (size_t)(j - 1) * DM; } break;
    case 9: S.type = ST_MIX; S.sync = 1; S.i0 = 5; S.i1 = 0; S.i2 = j; break;
    case 10: S.type = ST_GEMM; S.g = pg8::Gemm{A1, (const bf16_t*)(RW + RW_G1), MR, 256, DM, DM, DM, 0, 0}; S.e.O = GLb; S.e.ldc = 128; S.e.nstore = 128; S.e.act = 2; break;
    case 11: S.type = ST_GEMM; S.sync = 1; S.g = pg8::Gemm{A2, (const bf16_t*)(RW + RW_R), MR, DM, DM, DM, DM, 240, 0}; S.e.O = A0; break;
    case 12: S.type = ST_SCAN; S.sync = 1; S.i0 = j; break;
    case 13: S.type = ST_POST; S.sync = 1; S.i0 = j; break;
    case 14: S.type = ST_GEMM; S.sync = 1; S.g = pg8::Gemm{GLb, (const bf16_t*)(RW + RW_G2), lastl ? NB * TL : MR, DM, 128, 128, 128, 0, lastl}; S.e.mode = EM_MULZ; S.e.O = A4; break;
    default: S.type = ST_GEMM; S.sync = 1; S.g = pg8::Gemm{A4, (const bf16_t*)(RW + RW_O), lastl ? NB * TL : MR, DM, DM, DM, DM, 0, lastl}; S.e.mode = EM_RES; S.e.f0 = mod; S.e.k = 2; S.e.row_off = 0; break;
    }
}

template <int TYPE> __device__ __forceinline__ void run_step(const Params& P, unsigned char* ws, const Step& S, LAS unsigned char* lds, unsigned char* lds_raw) {
    float* XL = P.out; float* XC = (float*)(ws + WS_CTXR);
    bf16_t* A0 = (bf16_t*)(ws + WS_A0); bf16_t* A1 = (bf16_t*)(ws + WS_A1); bf16_t* A2 = (bf16_t*)(ws + WS_A2); bf16_t* A3 = (bf16_t*)(ws + WS_A3); bf16_t* A4 = (bf16_t*)(ws + WS_A4);
    const float* MOD = (const float*)(ws + WS_MOD);
    float* KN = (float*)(ws + WS_KNORM); float* CB = (float*)(ws + WS_CB2);
    if constexpr (TYPE == ST_P0) { phase_p0(P, ws, lds); }
    else if constexpr (TYPE == ST_NORM) {
        const int layer = S.i0; const float* mod = MOD + (size_t)layer * 17 * 6144;
        const float* g = (S.i1 ? P.in[7] : P.in[6]) + layer * DM;
        bf16_t* HB = S.i1 ? (bf16_t*)(ws + WS_A4 + 16 * MiB) : nullptr;
        if (S.i2) phase_norm_mod(P.in[0], P.in[2], XL, XC, g, mod, S.i1, A0, HB);
        else phase_norm_mod(XL, XC, nullptr, nullptr, g, mod, S.i1, A0, HB);
    }
    else if constexpr (TYPE == ST_GEMM) { EpiGen e = S.e; e.ldsb = (unsigned)(uintptr_t)lds + 131072u; pg8::gemm_phase(lds, S.g, e); }
    else if constexpr (TYPE == ST_ATTN) {
        const int j = S.i0; const float lambda_init = (S.i1 == 0) ? 0.2f : 0.47071301835f;
        phase_attn(A1, A2, A3, A0, (float*)A4, P.in[13] + j * 256, lambda_init, P.in[14] + j * 128, (char*)lds_raw);
    }
    else if constexpr (TYPE == ST_MIX) {
        const int j = S.i2 & 255; const bool kn = (S.i2 & 256) != 0;
        const float* mp = P.in[16] + (size_t)j * 6 * DM; const float* mn = P.in[17] + (size_t)j * 6 * DM;
        phase_mix(A0, mp, mn, S.i0, S.i1, A1, A2, kn ? A4 : nullptr, P.in[30] + j * DM, kn ? KN : nullptr);
    }
    else if constexpr (TYPE == ST_SCAN) {
        const int j = S.i0; const unsigned char* RW = ws + WS_W + W_RWB(j);
        ScanArgs SA{A0, A4, S.Vb, (bf16_t*)(ws + WS_LORA), (bf16_t*)(ws + WS_LORA + LORA_SZ), KN, (const bf16_t*)(RW + RW_W2), (const bf16_t*)(RW + RW_A2), P.in[21] + (size_t)j * 2 * DM, P.in[24] + (size_t)j * 2 * DM,
                    P.in[30] + j * DM, P.in[31] + j * DM, P.in[32] + j * DM, A1, A2, CB};
        phase_scan(SA, lds);
    }
    else if constexpr (TYPE == ST_POST) { const int j = S.i0; phase_post(A1, A2, S.Vb, CB, P.in[35] + j * DM, P.in[36] + j * DM, A4); }
    else if constexpr (TYPE == ST_CONV) { const int layer = S.i0; phase_convact(A1, A4, S.i1, S.i2, P.in[9] + (size_t)layer * 3 * DFF, P.in[10] + (size_t)layer * DFF); }
    else if constexpr (TYPE == ST_FINAL) { phase_final_norm(XL, P.in[38]); }
}

#ifndef FUSED
#define FUSED 1
#endif
#if FUSED
__global__ void __launch_bounds__(NTHR, 2) fwd_megakernel(Params P) {
    extern __shared__ __attribute__((aligned(16))) unsigned char lds_raw[];
    LAS unsigned char* lds = (LAS unsigned char*)lds_raw;
    cg::grid_group grid = cg::this_grid();
    volatile LAS unsigned* bst = (volatile LAS unsigned*)(lds + 147456);
    if (threadIdx.x < 2) bst[threadIdx.x] = 0u;
    __syncthreads();
    for (int st = 0; st < NSTEPS; ++st) {
        unsigned char* ws;
        { unsigned lo = P.ws_lo, hi = P.ws_hi;
          asm volatile("" : "+s"(lo), "+s"(hi));
          typedef __attribute__((address_space(1))) unsigned char gbyte_t;
          ws = (unsigned char*)(gbyte_t*)(((uintptr_t)hi << 32) | (uintptr_t)lo); }
        Step S; make_step(st, P, ws, S);
        switch (S.type) {
        case ST_P0: run_step<ST_P0>(P, ws, S, lds, lds_raw); break;
        case ST_NORM: run_step<ST_NORM>(P, ws, S, lds, lds_raw); break;
        case ST_GEMM: run_step<ST_GEMM>(P, ws, S, lds, lds_raw); break;
        case ST_ATTN: run_step<ST_ATTN>(P, ws, S, lds, lds_raw); break;
        case ST_MIX: run_step<ST_MIX>(P, ws, S, lds, lds_raw); break;
        case ST_SCAN: run_step<ST_SCAN>(P, ws, S, lds, lds_raw); break;
        case ST_POST: run_step<ST_POST>(P, ws, S, lds, lds_raw); break;
        case ST_CONV: run_step<ST_CONV>(P, ws, S, lds, lds_raw); break;
        case ST_FINAL: run_step<ST_FINAL>(P, ws, S, lds, lds_raw); break;
        default: break;
        }
#if defined(PROBE_DUP)
        if (S.type == PROBE_DUP) {
            grid.sync();
            switch (S.type) {
            case ST_ATTN: run_step<ST_ATTN>(P, ws, S, lds, lds_raw); break;
            case ST_SCAN: run_step<ST_SCAN>(P, ws, S, lds, lds_raw); break;
            case ST_CONV: run_step<ST_CONV>(P, ws, S, lds, lds_raw); break;
            case ST_MIX: run_step<ST_MIX>(P, ws, S, lds, lds_raw); break;
            case ST_NORM: run_step<ST_NORM>(P, ws, S, lds, lds_raw); break;
            case ST_POST: run_step<ST_POST>(P, ws, S, lds, lds_raw); break;
            case ST_P0: run_step<ST_P0>(P, ws, S, lds, lds_raw); break;
            default: break;
            }
        }
#endif
        if (S.sync) { if (st == 0) { grid.sync(); (void)xcd_barrier_post((unsigned*)(ws + WS_BAR), bst); } else { XcdBarrier xb; xb.bar = (unsigned*)(ws + WS_BAR); xb.x = xb_xcc_id(); xb.st = (volatile LAS unsigned*)(lds + 147456); xcd_barrier(xb); } }
#if defined(PROBE_SYNC)
        if (S.sync) { grid.sync(); grid.sync(); }
#endif
    }
}
#else
template <int TYPE> __global__ void __launch_bounds__(NTHR, 2) k_step(Params P, int st) {
    extern __shared__ __attribute__((aligned(16))) unsigned char lds_raw[];
    LAS unsigned char* lds = (LAS unsigned char*)lds_raw;
    Step S; make_step(st, P, P.ws, S);
    run_step<TYPE>(P, P.ws, S, lds, lds_raw);
}
template <int TYPE> static void launch_step(const Params& P, int st, int grid, hipStream_t stream) {
    static bool attr_done = false;
    if (!attr_done) { (void)hipFuncSetAttribute((const void*)k_step<TYPE>, hipFuncAttributeMaxDynamicSharedMemorySize, LDS_BYTES); attr_done = true; }
    hipLaunchKernelGGL(k_step<TYPE>, dim3(grid), dim3(NTHR), LDS_BYTES, stream, P, st);
}
#endif

extern "C" void kernel_launch(void* const* d_in, const int* in_sizes, int n_in, void* d_out, int out_size, void* d_ws, size_t ws_size, hipStream_t stream) {
    static int grid = 0;
    if (grid == 0) {
        if (n_in != 39 || out_size != NB * TL * DM || ws_size < WS_END) { fprintf(stderr, "kernel_launch: unexpected shapes n_in %d out %d ws %zu (need %zu)\n", n_in, out_size, ws_size, (size_t)WS_END); grid = -1; return; }
        int dev = 0, cus = 0, per_cu = 1;
        (void)hipGetDevice(&dev); (void)hipDeviceGetAttribute(&cus, hipDeviceAttributeMultiprocessorCount, dev);
#if FUSED
        if (hipFuncSetAttribute((const void*)fwd_megakernel, hipFuncAttributeMaxDynamicSharedMemorySize, LDS_BYTES) != hipSuccess) { fprintf(stderr, "kernel_launch: hipFuncSetAttribute failed\n"); grid = -1; return; }
        if (hipOccupancyMaxActiveBlocksPerMultiprocessor(&per_cu, (const void*)fwd_megakernel, NTHR, LDS_BYTES) != hipSuccess || per_cu < 1) { fprintf(stderr, "kernel_launch: occupancy query gave %d\n", per_cu); per_cu = 1; }
        (void)hipGetLastError();
#endif
        grid = cus * per_cu;
        fprintf(stderr, "kernel_launch: grid %d (cus %d x %d), ws %zu\n", grid, cus, per_cu, ws_size);
    }
    if (grid < 0) return;
    Params P; memset(&P, 0, sizeof(P));
    for (int i = 0; i < 39; ++i) P.in[i] = (const float*)d_in[i];
    P.out = (float*)d_out; P.ws = (unsigned char*)d_ws; P.ws_lo = (unsigned)((uintptr_t)d_ws & 0xffffffffu); P.ws_hi = (unsigned)((uintptr_t)d_ws >> 32);
    unsigned char* WBh = (unsigned char*)d_ws + WS_W;
    int nj = 0;
    auto add = [&](const float* src, size_t dst_off, int Ksrc, int Kdst, int Nsrc, int Ndst, int dld, int perm) {
        TJob& J = P.jobs[nj++]; J.src = src; J.dst = (bf16_t*)(WBh + dst_off); J.Ksrc = Ksrc; J.Kdst = Kdst; J.Nsrc = Nsrc; J.Ndst = Ndst; J.dld = dld; J.perm = perm; };
    for (int j = 0; j < 2; ++j) {
        add(P.in[12] + (size_t)j * DM * 3072, W_QKV(j), DM, DM, 3072, 3072, DM, 1);
        add(P.in[15] + (size_t)j * DM * DM, W_AO(j), DM, DM, DM, DM, DM, 0);
    }
    for (int i = 0; i < 4; ++i) {
        add(P.in[8] + (size_t)i * DM * 2 * DFF, W_UP2(i), DM, DM, 2 * DFF, 2 * DFF, DM, 2);
        add(P.in[11] + (size_t)i * DFF * DM, W_DN2(i), DFF, DFF, DM, DM, DFF, 0);
    }
    for (int j = 0; j < 2; ++j) {
        const size_t rb = W_RWB(j);
        add(P.in[18] + (size_t)j * DM * DM, rb + RW_R, DM, DM, DM, DM, DM, 0);
        add(P.in[19] + (size_t)j * DM * DM, rb + RW_K, DM, DM, DM, DM, DM, 0);
        add(P.in[20] + (size_t)j * DM * DM, rb + RW_V, DM, DM, DM, DM, DM, 0);
        add(P.in[37] + (size_t)j * DM * DM, rb + RW_O, DM, DM, DM, DM, DM, 0);
        add(P.in[22] + ((size_t)j * 2 + 0) * DM * 64, rb + RW_W1, DM, DM, 64, 64, DM, 0);
        add(P.in[22] + ((size_t)j * 2 + 1) * DM * 64, rb + RW_W1 + (size_t)64 * DM * 2, DM, DM, 64, 192, DM, 0);
        add(P.in[25] + ((size_t)j * 2 + 0) * DM * 64, rb + RW_A1, DM, DM, 64, 64, DM, 0);
        add(P.in[25] + ((size_t)j * 2 + 1) * DM * 64, rb + RW_A1 + (size_t)64 * DM * 2, DM, DM, 64, 192, DM, 0);
        add(P.in[33] + (size_t)j * DM * 128, rb + RW_G1, DM, DM, 128, 256, DM, 0);
        if (j > 0) add(P.in[28] + (size_t)(j - 1) * DM * 32, rb + RW_V1, DM, DM, 32, 256, DM, 0);
        add(P.in[34] + (size_t)j * 128 * DM, rb + RW_G2, 128, 128, DM, DM, 128, 0);
        if (j > 0) add(P.in[29] + (size_t)(j - 1) * 32 * DM, rb + RW_V2, 32, 128, DM, DM, 128, 0);
        for (int d = 0; d < 2; ++d) {
            add(P.in[23] + ((size_t)j * 2 + d) * 64 * DM, rb + RW_W2 + (size_t)d * DM * 64 * 2, 64, 64, DM, DM, 64, 0);
            add(P.in[26] + ((size_t)j * 2 + d) * 64 * DM, rb + RW_A2 + (size_t)d * DM * 64 * 2, 64, 64, DM, DM, 64, 0);
        }
    }
    P.njobs = nj;
#if FUSED
    void* args[] = {&P};
    hipError_t e = hipLaunchCooperativeKernel((const void*)fwd_megakernel, dim3(grid), dim3(NTHR), args, LDS_BYTES, stream);
    if (e != hipSuccess) fprintf(stderr, "cooperative launch failed: %s (grid %d)\n", hipGetErrorString(e), grid);
#else
    for (int st = 0; st < NSTEPS; ++st) {
        Step S; make_step(st, P, P.ws, S);
        switch (S.type) {
        case ST_P0: launch_step<ST_P0>(P, st, grid, stream); break;
        case ST_NORM: launch_step<ST_NORM>(P, st, grid, stream); break;
        case ST_GEMM: launch_step<ST_GEMM>(P, st, grid, stream); break;
        case ST_ATTN: launch_step<ST_ATTN>(P, st, grid, stream); break;
        case ST_MIX: launch_step<ST_MIX>(P, st, grid, stream); break;
        case ST_SCAN: launch_step<ST_SCAN>(P, st, grid, stream); break;
        case ST_POST: launch_step<ST_POST>(P, st, grid, stream); break;
        case ST_CONV: launch_step<ST_CONV>(P, st, grid, stream); break;
        case ST_FINAL: launch_step<ST_FINAL>(P, st, grid, stream); break;
        default: break;
        }
    }
#endif
}
```

```cpp
#include <hip/hip_runtime.h>
#include <hip/hip_cooperative_groups.h>
#include <cstdio>
#include <cstdint>
#include <cstring>
namespace cg = cooperative_groups;

#define LAS __attribute__((address_space(3)))
typedef unsigned short bf16_t;
typedef short bf16x8 __attribute__((ext_vector_type(8)));
typedef short s16x4 __attribute__((ext_vector_type(4)));
typedef float f32x4 __attribute__((ext_vector_type(4)));
typedef float f32x2 __attribute__((ext_vector_type(2)));
typedef float f32x16 __attribute__((ext_vector_type(16)));
typedef unsigned u32x4 __attribute__((ext_vector_type(4)));
typedef unsigned u32x2 __attribute__((ext_vector_type(2)));

constexpr int DM = 1024, NB = 16, TL = 4096, TC = 256, PB = TL + TC  , MR = NB * PB  ;
constexpr int DFF = 2816, NLAYER = 4;
constexpr int NWAVES = 8, NTHR = 512;
constexpr int LDS_BYTES = 155648;
constexpr size_t MiB = 1u << 20;
constexpr size_t WS_ROPE = 0;
constexpr size_t WS_BAR = 64 * 1024;
constexpr size_t WS_MOD = 1 * MiB;
constexpr size_t WS_KNORM = 3 * MiB;
constexpr size_t WS_W = 16 * MiB;
constexpr size_t WS_CTXR = 120 * MiB;
constexpr size_t WS_VF = 136 * MiB;
constexpr size_t WS_A0 = 272 * MiB, ABLK = 136 * MiB;
constexpr size_t WS_A1 = WS_A0 + ABLK, WS_A2 = WS_A1 + ABLK, WS_A3 = WS_A2 + ABLK, WS_A4 = WS_A3 + ABLK;
constexpr size_t WS_LORA = 952 * MiB;
constexpr size_t LORA_SZ = 17 * MiB;
constexpr size_t WS_END = 1020 * MiB;
constexpr size_t WS_CB2 = (size_t)(7.5 * 1048576.0);

__device__ __forceinline__ int tid_() { int t = threadIdx.x; asm volatile("" : "+v"(t)); return t; }
__device__ __forceinline__ int bid_() { int b = blockIdx.x; asm volatile("" : "+s"(b)); return b; }
__device__ __forceinline__ int gdim_() { int g = gridDim.x; asm volatile("" : "+s"(g)); return g; }
__device__ __forceinline__ unsigned cvt_pk_bf16(float lo, float hi) { unsigned r; asm volatile("v_cvt_pk_bf16_f32 %0, %1, %2" : "=v"(r) : "v"(lo), "v"(hi)); return r; }
__device__ __forceinline__ float bflo(unsigned w) { return __uint_as_float(w << 16); }
__device__ __forceinline__ float bfhi(unsigned w) { return __uint_as_float(w & 0xffff0000u); }
__device__ __forceinline__ float bf2f(bf16_t h) { return __uint_as_float((unsigned)h << 16); }
__device__ __forceinline__ float wave_sum(float v) {
#pragma unroll
    for (int o = 1; o < 64; o <<= 1) v += __shfl_xor(v, o);
    return v;
}
__device__ __forceinline__ float dpp_f(float x, const int ctrl_dummy) { return x; }
#define DPP_ADD(x, ctrl) ((x) + __int_as_float(__builtin_amdgcn_update_dpp(0, __float_as_int(x), (ctrl), 0xF, 0xF, true)))
__device__ __forceinline__ float red4(float x) { x = DPP_ADD(x, 0xB1); x = DPP_ADD(x, 0x4E); return x; }
__device__ __forceinline__ float red8(float x) { x = red4(x); x = DPP_ADD(x, 0x141); return x; }
__device__ __forceinline__ float red16(float x) { x = red8(x); x = DPP_ADD(x, 0x140); return x; }
__device__ __forceinline__ float sigmoidf_(float x) { return __builtin_amdgcn_rcpf(1.f + __expf(-x)); }
__device__ __forceinline__ void unpack8(u32x4 w, float* f) { f[0] = bflo(w.x); f[1] = bfhi(w.x); f[2] = bflo(w.y); f[3] = bfhi(w.y); f[4] = bflo(w.z); f[5] = bfhi(w.z); f[6] = bflo(w.w); f[7] = bfhi(w.w); }
__device__ __forceinline__ u32x4 pack8(const float* f) { u32x4 w; w.x = cvt_pk_bf16(f[0], f[1]); w.y = cvt_pk_bf16(f[2], f[3]); w.z = cvt_pk_bf16(f[4], f[5]); w.w = cvt_pk_bf16(f[6], f[7]); return w; }


#define XB_TMO      128
#define XB_XCNT(j)  (256  + 64 * (j))
#define XB_XSUB(j)  (1280 + 64 * (j))
#define XB_XGEN(j)  (2304 + 64 * (j))
#define XB_TOP      3328
#define XB_TOPGEN   3392
#define XCD_BAR_WORDS 3456
#define XB_SPIN_CAP (1u << 22)
__device__ __forceinline__ unsigned xb_ld(unsigned* p)              { return __hip_atomic_load(p, __ATOMIC_RELAXED, __HIP_MEMORY_SCOPE_AGENT); }
__device__ __forceinline__ unsigned xb_add(unsigned* p, unsigned v) { return __hip_atomic_fetch_add(p, v, __ATOMIC_RELAXED, __HIP_MEMORY_SCOPE_AGENT); }
__device__ __forceinline__ unsigned xb_xcc_id() { return (unsigned)__builtin_amdgcn_s_getreg((3 << 11) | 20) & 0xFu; }
#define XB_SPIN(cond, bar) do { unsigned _sp = 0; while (cond) { __builtin_amdgcn_s_sleep(1); \
    if ((++_sp & 255u) == 0u) { if (xb_ld(&(bar)[XB_TMO])) break; if (_sp > XB_SPIN_CAP) { atomicAdd(&(bar)[XB_TMO], 1u); break; } } } } while (0)
struct XcdBarrier { unsigned* bar; unsigned x; volatile LAS unsigned* st; };
__device__ __forceinline__ XcdBarrier xcd_barrier_post(unsigned* bar, volatile LAS unsigned* st) {
    XcdBarrier b; b.bar = bar; b.x = xb_xcc_id(); b.st = st;
    if (threadIdx.x == 0) (void)xb_add(&bar[XB_XCNT(b.x)], 1u);
    return b;
}
__device__ __forceinline__ void xcd_barrier_complete(unsigned* bar, unsigned x, unsigned& nloc, unsigned& nx) {
    const unsigned G = gridDim.x * gridDim.y * gridDim.z;
    unsigned sum, cnt, mine, sp = 0u;
    for (;;) {
        sum = 0u; cnt = 0u; mine = 0u;
#pragma unroll
        for (unsigned j = 0; j < 16; ++j) { const unsigned c = xb_ld(&bar[XB_XCNT(j)]); sum += c; cnt += (c > 0u) ? 1u : 0u; mine = (j == x) ? c : mine; }
        if (sum == G) break;
        __builtin_amdgcn_s_sleep(1);
        if ((++sp & 255u) == 0u) { if (xb_ld(&bar[XB_TMO])) break; if (sp > XB_SPIN_CAP) { atomicAdd(&bar[XB_TMO], 1u); break; } }
    }
    nloc = mine > 0u ? mine : 1u; nx = cnt > 0u ? cnt : 1u;
}
__device__ __forceinline__ void xcd_barrier(const XcdBarrier& b) {
    asm volatile("s_waitcnt vmcnt(0)" ::: "memory");
    __syncthreads();
    if (threadIdx.x == 0) {
        unsigned* bar = b.bar;
        __builtin_amdgcn_s_waitcnt(0);
        unsigned nloc = b.st[0], nx = b.st[1];
        if (nloc == 0u) { xcd_barrier_complete(bar, b.x, nloc, nx); b.st[0] = nloc; b.st[1] = nx; }
        const unsigned old = xb_add(&bar[XB_XSUB(b.x)], 1u);
        const unsigned gen = old / nloc;
        if (old + 1u == (gen + 1u) * nloc) {
            __builtin_amdgcn_fence(__ATOMIC_RELEASE, "agent");
            asm volatile("s_waitcnt vmcnt(0)" ::: "memory");
            const unsigned og = xb_add(&bar[XB_TOP], 1u);
            const unsigned tg = og / nx;
            if (og + 1u == (tg + 1u) * nx) xb_add(&bar[XB_TOPGEN], 1u);
            else XB_SPIN(xb_ld(&bar[XB_TOPGEN]) == tg, bar);
            __builtin_amdgcn_fence(__ATOMIC_ACQUIRE, "agent");
            xb_add(&bar[XB_XGEN(b.x)], 1u);
            asm volatile("s_waitcnt vmcnt(0)" ::: "memory");
        } else {
            XB_SPIN(xb_ld(&bar[XB_XGEN(b.x)]) == gen, bar);
            __builtin_amdgcn_fence(__ATOMIC_ACQUIRE, "agent");
            asm volatile("s_waitcnt vmcnt(0)" ::: "memory");
        }
    }
    __syncthreads();
}

namespace pg8 {
constexpr int BM = 256, BK = 64, HALF = 128, HTB = HALF * BK * 2, STAGE_BYTES = 8 * HTB, NXCD = 8, WGM = 8;
__host__ __device__ __forceinline__ int lds_byte(int r, int c) { const int st = (r >> 4) * 2 + (c >> 5), rr = r & 15, cc = c & 31, ob = rr * 64 + cc * 2; return st * 1024 + (ob ^ (((ob >> 9) & 1) << 5)); }
__host__ __device__ __forceinline__ void stage_rc(int b, int& R, int& C) { const int st = b / 1024, sb = b % 1024, swz = sb ^ (((sb >> 9) & 1) << 5); R = (st >> 1) * 16 + swz / 64; C = (st & 1) * 32 + (swz % 64) / 2; }
__host__ __device__ __forceinline__ int perm32(int rho) { const int n = rho >> 4, i = rho & 15; return 8 * (i >> 2) + 4 * n + (i & 3); }
struct Unit { int pm, pn; };
struct Gemm { const bf16_t* A; const bf16_t* Bt; int M, N, K, lda, ldb; int rot, lat_only; };
struct StaticOrder {
    int nM, nN, nwg, G, c, lat;
    __device__ void init(int M, int N, int G_, int c_, int lat_) { nM = M / BM; nN = N / BM; nwg = nM * nN; G = G_; c = c_; lat = lat_; }
    __device__ bool next(int i, Unit& u) const {
        const long L = (long)i * G + c; if (L >= nwg) return false;
        int wgid = (int)L; { const int q = nwg / NXCD, r = nwg % NXCD, xcd = wgid % NXCD, off = wgid / NXCD; wgid = (xcd < r ? xcd * (q + 1) : r * (q + 1) + (xcd - r) * q) + off; }
        const int nig = WGM * nN, gid = wgid / nig, fm = gid * WGM, gsz = (nM - fm) < WGM ? (nM - fm) : WGM;
        u.pm = fm + ((wgid % nig) % gsz); u.pn = (wgid % nig) / gsz;
        if (lat) u.pm = (u.pm >> 4) * 17 + 1 + (u.pm & 15);
        return true;
    }
};
template <class Epi>
__device__ __forceinline__ void gemm_phase(LAS unsigned char* lds, const Gemm g, const Epi& E) {
    StaticOrder S; { const int G_ = gdim_(); int c_ = bid_() + g.rot; if (c_ >= G_) c_ -= G_; S.init(g.M, g.N, G_, c_, g.lat_only); }
    const int tid = tid_(), wid = __builtin_amdgcn_readfirstlane(tid >> 6), lane = tid & 63, wr = wid >> 2, wc = wid & 3, fr = lane & 15, fq = lane >> 4;
    const int K = g.K, nt = K / BK;
    unsigned voffA[2], voffB[2];
#pragma unroll
    for (int i = 0; i < 2; ++i) { int R, C; stage_rc(tid * 16 + i * 8192, R, C); const int Rb = (R & ~31) + perm32(R & 31);
        voffA[i] = (unsigned)(R * g.lda + C) * 2u; voffB[i] = (unsigned)(Rb * g.ldb + C) * 2u; }
    const size_t kstep = (size_t)(BK * 2);
    const size_t hstepA = (size_t)HALF * g.lda * 2, hstepB = (size_t)HALF * g.ldb * 2;
    const size_t tstepA = 2 * hstepA, tstepB = 2 * hstepB;
    const unsigned ldsw = (unsigned)wid * 1024u;
    const int aoff = lds_byte(wr * 64 + fr, fq * 8), boff = lds_byte(wc * 32 + fr, fq * 8);
#define PG8_SA(b, h) (((b) * 2 + (h)) * HTB)
#define PG8_SB(b, h) ((4 + (b) * 2 + (h)) * HTB)
#define PG8_STAGE(bufoff, gbase, voff) do { _Pragma("unroll") for (int _i = 0; _i < 2; ++_i) \
        __builtin_amdgcn_global_load_lds((const unsigned*)((const char*)(gbase) + (voff)[_i]), (LAS unsigned*)(lds + (bufoff) + ldsw + _i * 8192), 16, 0, 0); } while (0)
#define PG8_LDA(dst, b, h) do { _Pragma("unroll") for (int m = 0; m < 4; ++m) _Pragma("unroll") for (int k = 0; k < 2; ++k) dst[m][k] = *(const LAS bf16x8*)(lds + PG8_SA(b, h) + aoff + m * 2048 + k * 1024); } while (0)
#define PG8_LDB(dst, b, h) do { _Pragma("unroll") for (int n = 0; n < 2; ++n) _Pragma("unroll") for (int k = 0; k < 2; ++k) dst[n][k] = *(const LAS bf16x8*)(lds + PG8_SB(b, h) + boff + n * 2048 + k * 1024); } while (0)
#define PG8_MMA(ai, bj, At, Bt) do { __builtin_amdgcn_s_setprio(1); _Pragma("unroll") for (int m = 0; m < 4; ++m) _Pragma("unroll") for (int n = 0; n < 2; ++n) _Pragma("unroll") for (int k = 0; k < 2; ++k) \
        acc[ai][bj][m][n] = __builtin_amdgcn_mfma_f32_16x16x32_bf16(Bt[n][k], At[m][k], acc[ai][bj][m][n], 0, 0, 0); __builtin_amdgcn_s_setprio(0); } while (0)
#define PG8_WAIT_V(n) asm volatile("s_waitcnt vmcnt(" #n ")" ::: "memory")
#define PG8_WAIT_L(n) asm volatile("s_waitcnt lgkmcnt(" #n ")" ::: "memory")
#define PG8_BAR __builtin_amdgcn_s_barrier()
#define PG8_SCHED __builtin_amdgcn_sched_barrier(0)
    Unit cur, nxt; int ui = 0;
    if (!S.next(0, cur)) return;
    f32x4 acc[2][2][4][2];
#pragma unroll
    for (int a = 0; a < 2; ++a)
#pragma unroll
        for (int b = 0; b < 2; ++b)
#pragma unroll
            for (int m = 0; m < 4; ++m)
#pragma unroll
                for (int n = 0; n < 2; ++n) acc[a][b][m][n] = (f32x4){0.f, 0.f, 0.f, 0.f};
    bf16x8 At[4][2], B0[2][2], B1[2][2];
    const char* cA = (const char*)g.A + (size_t)cur.pm * tstepA; const char* cB = (const char*)g.Bt + (size_t)cur.pn * tstepB;
    PG8_STAGE(PG8_SB(0, 0), cB, voffB); PG8_STAGE(PG8_SB(0, 1), cB + hstepB, voffB); PG8_STAGE(PG8_SA(0, 0), cA, voffA); PG8_STAGE(PG8_SA(0, 1), cA + hstepA, voffA);
    if (wr == 1) PG8_BAR;
    PG8_WAIT_V(2); PG8_BAR;
    PG8_STAGE(PG8_SB(1, 0), cB + kstep, voffB); PG8_STAGE(PG8_SA(1, 0), cA + kstep, voffA); PG8_STAGE(PG8_SB(1, 1), cB + hstepB + kstep, voffB);
    PG8_WAIT_V(6); PG8_BAR;
    for (;;) {
        const bool has_next = S.next(ui + 1, nxt);
        const char* nA = has_next ? (const char*)g.A + (size_t)nxt.pm * tstepA : cA; const char* nB = has_next ? (const char*)g.Bt + (size_t)nxt.pn * tstepB : cB;
        for (int t = 0; t < nt; t += 2) {
            const bool last = (t == nt - 2);
            const char* a1 = cA + (size_t)(t + 1) * kstep;
            const char* a2 = last ? nA : cA + (size_t)(t + 2) * kstep; const char* b2 = last ? nB : cB + (size_t)(t + 2) * kstep;
            const char* a3 = a2 + kstep; const char* b3 = b2 + kstep;
            PG8_LDB(B0, 0, 0); PG8_LDB(B1, 0, 1); PG8_SCHED; PG8_LDA(At, 0, 0); PG8_STAGE(PG8_SA(1, 1), a1 + hstepA, voffA);
            PG8_WAIT_V(8); PG8_WAIT_L(0); PG8_BAR; PG8_MMA(0, 0, At, B0); PG8_MMA(0, 1, At, B1); PG8_BAR; PG8_SCHED;
            PG8_LDA(At, 0, 1); PG8_STAGE(PG8_SB(0, 0), b2, voffB); PG8_STAGE(PG8_SB(0, 1), b2 + hstepB, voffB); PG8_STAGE(PG8_SA(0, 0), a2, voffA);
            PG8_WAIT_V(8); PG8_WAIT_L(0); PG8_BAR; PG8_MMA(1, 0, At, B0); PG8_MMA(1, 1, At, B1); PG8_BAR; PG8_SCHED;
            PG8_LDB(B0, 1, 0); PG8_LDB(B1, 1, 1); PG8_SCHED; PG8_LDA(At, 1, 0); PG8_STAGE(PG8_SA(0, 1), a2 + hstepA, voffA);
            PG8_WAIT_V(8); PG8_WAIT_L(0); PG8_BAR; PG8_MMA(0, 0, At, B0); PG8_MMA(0, 1, At, B1); PG8_BAR; PG8_SCHED;
            PG8_LDA(At, 1, 1); PG8_STAGE(PG8_SB(1, 0), b3, voffB); PG8_STAGE(PG8_SB(1, 1), b3 + hstepB, voffB); PG8_STAGE(PG8_SA(1, 0), a3, voffA);
            PG8_WAIT_V(8); PG8_WAIT_L(0); PG8_BAR; PG8_MMA(1, 0, At, B0); PG8_MMA(1, 1, At, B1); PG8_BAR; PG8_SCHED;
        }
        if (wr == 0) PG8_BAR;
        E(acc, cur, wr, wc, fr, fq);
        if (!has_next) break;
#pragma unroll
        for (int a = 0; a < 2; ++a)
#pragma unroll
            for (int b = 0; b < 2; ++b)
#pragma unroll
                for (int m = 0; m < 4; ++m)
#pragma unroll
                    for (int n = 0; n < 2; ++n) acc[a][b][m][n] = (f32x4){0.f, 0.f, 0.f, 0.f};
        cur = nxt; cA = nA; cB = nB; ++ui;
        if (wr == 1) PG8_BAR;
    }
    PG8_WAIT_V(0);
    PG8_BAR;
#undef PG8_SA
#undef PG8_SB
#undef PG8_STAGE
#undef PG8_LDA
#undef PG8_LDB
#undef PG8_MMA
#undef PG8_WAIT_V
#undef PG8_WAIT_L
#undef PG8_BAR
#undef PG8_SCHED
}
}

enum { EM_BF16 = 0, EM_QKV = 1, EM_RES = 2, EM_VMIX = 3, EM_MULZ = 4, EM_GLU = 5 };
struct EpiGen {
    int mode; bf16_t* O; bf16_t* O2; bf16_t* O3; const bf16_t* VFp; const float* f0; const float* f1; float* XL; float* XC; int ldc, nstore, act, k, row_off; unsigned ldsb;
    template <int mode> __device__ __forceinline__ void each(int row, int col, float* v) const {
        if (mode == EM_BF16) {
            if (col >= nstore) return;
            if (act == 1) { for (int i = 0; i < 8; ++i) v[i] = tanhf(v[i]); }
            else if (act == 2) { for (int i = 0; i < 8; ++i) v[i] = sigmoidf_(v[i]); }
            *(u32x4*)(O + (size_t)row * ldc + col) = pack8(v);
        } else if (mode == EM_QKV) {
            const int which = col >> 10, c = col & 1023;
            bf16_t* base = O + (size_t)which * (ABLK / 2);
            const int b = row / PB, p = row - b * PB;
            if (which < 2 && p >= TC) {
                const int t = p - TC; const int g = (c & 63) >> 3;
                const int pos = (g < 4) ? (t >> 6) : (t & 63); const int fo = (g & 3) * 4;
                const f32x4* rp = (const f32x4*)(f0 + (pos * 16 + fo) * 2);
                const f32x4 r0 = rp[0], r1 = rp[1];
                const f32x4 cs = {r0[0], r0[2], r1[0], r1[2]}, sn = {r0[1], r0[3], r1[1], r1[3]};
                const f32x4 t1 = {v[0], v[1], v[2], v[3]}, t2 = {v[4], v[5], v[6], v[7]};
                const f32x4 n1 = t1 * cs - t2 * sn, n2 = t2 * cs + t1 * sn;
                v[0] = n1[0]; v[1] = n1[1]; v[2] = n1[2]; v[3] = n1[3]; v[4] = n2[0]; v[5] = n2[1]; v[6] = n2[2]; v[7] = n2[3];
            }
            *(u32x4*)(base + (size_t)row * DM + c) = pack8(v);
        } else if (mode == EM_RES) {
            const int r = row + row_off; const int b = r / PB, p = r - b * PB;
            float* x; const float* md;
            if (p < TC) { x = XC + ((size_t)(b * TC + p)) * DM + col; md = f0 + (size_t)16 * 6144 + k * DM + col; }
            else { x = XL + ((size_t)(b * TL + p - TC)) * DM + col; md = f0 + (size_t)b * 6144 + k * DM + col; }
            f32x4 x0 = *(f32x4*)x, x1 = *(f32x4*)(x + 4); const f32x4 m0 = *(const f32x4*)md, m1 = *(const f32x4*)(md + 4);
            x0[0] += m0[0] * v[0]; x0[1] += m0[1] * v[1]; x0[2] += m0[2] * v[2]; x0[3] += m0[3] * v[3];
            x1[0] += m1[0] * v[4]; x1[1] += m1[1] * v[5]; x1[2] += m1[2] * v[6]; x1[3] += m1[3] * v[7];
            *(f32x4*)x = x0; *(f32x4*)(x + 4) = x1;
        } else if (mode == EM_VMIX) {
            float a[8], f[8]; unpack8(*(const u32x4*)(O + (size_t)row * DM + col), a); unpack8(*(const u32x4*)(VFp + (size_t)row * DM + col), f);
#pragma unroll
            for (int i = 0; i < 8; ++i) a[i] = a[i] + (f[i] - a[i]) * sigmoidf_(f0[col + i] + v[i]);
            *(u32x4*)(O + (size_t)row * DM + col) = pack8(a);
        } else {
            float a[8]; unpack8(*(const u32x4*)(O + (size_t)row * DM + col), a);
#pragma unroll
            for (int i = 0; i < 8; ++i) a[i] *= v[i];
            *(u32x4*)(O + (size_t)row * DM + col) = pack8(a);
        }
    }
    template <int MODE> __device__ __forceinline__ void run(const f32x4 (&acc)[2][2][4][2], const pg8::Unit& u, int wr, int wc, int fr, int fq) const {
        int fro = fr; asm volatile("" : "+v"(fro));
#pragma unroll
        for (int ai = 0; ai < 2; ++ai)
#pragma unroll
            for (int m = 0; m < 4; ++m) {
                const int row = u.pm * 256 + ai * 128 + wr * 64 + m * 16 + fro;
#pragma unroll
                for (int bj = 0; bj < 2; ++bj) {
                    const int col = u.pn * 256 + bj * 128 + wc * 32 + 8 * fq;
                    float v[8];
                    const f32x4 a0 = acc[ai][bj][m][0], a1 = acc[ai][bj][m][1];
                    v[0] = a0[0]; v[1] = a0[1]; v[2] = a0[2]; v[3] = a0[3]; v[4] = a1[0]; v[5] = a1[1]; v[6] = a1[2]; v[7] = a1[3];
                    each<MODE>(row, col, v);
                }
                asm volatile("" ::: "memory");
            }
    }
    __device__ __forceinline__ void run_glu(const f32x4 (&acc)[2][2][4][2], const pg8::Unit& u, int wr, int wc, int fr, int fq) const {
        LAS float* B = (LAS float*)((LAS unsigned char*)0 + ldsb);
        int fro = fr; asm volatile("" : "+v"(fro));
        int lidx = (wc * 2) * 16 + fq * 4; asm volatile("" : "+v"(lidx));
#pragma unroll
        for (int ai = 0; ai < 2; ++ai)
#pragma unroll
            for (int m = 0; m < 4; ++m) { const int g = ai * 8 + wr * 4 + m;
#pragma unroll
                for (int bj = 0; bj < 2; ++bj) {
                    if (fr == 0) *(LAS f32x4*)(B + (g * 2 + 0) * 128 + lidx + bj * 16) = acc[ai][bj][m][0];
                    if (fr == 15) *(LAS f32x4*)(B + (g * 2 + 1) * 128 + lidx + bj * 16) = acc[ai][bj][m][0];
                } }
        asm volatile("s_waitcnt lgkmcnt(0)" ::: "memory"); __builtin_amdgcn_s_barrier(); asm volatile("" ::: "memory");
        const int t17 = u.pm % 17; const bool tfirst = (t17 == 0) || (t17 == 1), tlast = (t17 == 0) || (t17 == 16);
#pragma unroll
        for (int bj = 0; bj < 2; ++bj) {
            int col = u.pn * 256 + bj * 128 + wc * 32 + 8 * fq; asm volatile("" : "+v"(col)); const int ch = (col >> 3) * 4;
            const f32x4 c0 = *(const f32x4*)(f0 + ch), c1 = *(const f32x4*)(f0 + DFF + ch), c2 = *(const f32x4*)(f0 + 2 * DFF + ch), cb = *(const f32x4*)(f1 + ch);
#pragma unroll
            for (int ai = 0; ai < 2; ++ai)
#pragma unroll
                for (int m = 0; m < 4; ++m) { const int g = ai * 8 + wr * 4 + m;
                    const int row = u.pm * 256 + g * 16 + fro;
                    const f32x4 gt = acc[ai][bj][m][0], vl = acc[ai][bj][m][1];
                    f32x4 gp, gn;
#pragma unroll
                    for (int i = 0; i < 4; ++i) { gp[i] = __int_as_float(__builtin_amdgcn_update_dpp(0, __float_as_int(gt[i]), 0x111, 0xF, 0xF, true));
                                                  gn[i] = __int_as_float(__builtin_amdgcn_update_dpp(0, __float_as_int(gt[i]), 0x101, 0xF, 0xF, true)); }
                    if (fr == 0) {
                        if (g > 0) gp = *(const LAS f32x4*)(B + ((g - 1) * 2 + 1) * 128 + lidx + bj * 16);
                        else if (!tfirst) { const u32x2 w = *(const u32x2*)(VFp + (size_t)(2 * (u.pm - 1)) * (2 * DFF) + col); gp = (f32x4){bflo(w.x), bfhi(w.x), bflo(w.y), bfhi(w.y)}; }
                        else gp = (f32x4){0.f, 0.f, 0.f, 0.f};
                    }
                    if (fr == 15) {
                        if (g < 15) gn = *(const LAS f32x4*)(B + ((g + 1) * 2 + 0) * 128 + lidx + bj * 16);
                        else if (!tlast) { const u32x2 w = *(const u32x2*)(VFp + (size_t)(2 * u.pm + 1) * (2 * DFF) + col); gn = (f32x4){bflo(w.x), bfhi(w.x), bflo(w.y), bfhi(w.y)}; }
                        else gn = (f32x4){0.f, 0.f, 0.f, 0.f};
                    }
                    float o[4];
#pragma unroll
                    for (int i = 0; i < 4; ++i) { const float x = gp[i] * c0[i] + gt[i] * c1[i] + gn[i] * c2[i] + cb[i]; o[i] = x * __builtin_amdgcn_rcpf(1.f + __expf(-x)) * vl[i]; }
                    u32x2 w; w.x = cvt_pk_bf16(o[0], o[1]); w.y = cvt_pk_bf16(o[2], o[3]);
                    *(u32x2*)(O + (size_t)row * DFF + ch) = w;
                    if (m & 1) asm volatile("" ::: "memory");
                }
        }
    }
    __device__ __forceinline__ void operator()(const f32x4 (&acc)[2][2][4][2], const pg8::Unit& u, int wr, int wc, int fr, int fq) const {
        switch (mode) {
        case EM_GLU: run_glu(acc, u, wr, wc, fr, fq); break;
        case EM_BF16: run<EM_BF16>(acc, u, wr, wc, fr, fq); break;
        case EM_QKV: run<EM_QKV>(acc, u, wr, wc, fr, fq); break;
        case EM_RES: run<EM_RES>(acc, u, wr, wc, fr, fq); break;
        case EM_VMIX: run<EM_VMIX>(acc, u, wr, wc, fr, fq); break;
        default: run<EM_MULZ>(acc, u, wr, wc, fr, fq); break;
        }
    }
};

struct TJob { const float* src; bf16_t* dst; int Ksrc, Kdst, Nsrc, Ndst, dld, perm; };
constexpr int MAXJOBS = 48;
struct Params { const float* in[39]; float* out; unsigned char* ws; int njobs; int pad; unsigned ws_lo, ws_hi; TJob jobs[MAXJOBS]; };

constexpr size_t W_QKV(int j) { return (size_t)j * 8 * MiB; }
constexpr size_t W_AO(int j) { return (size_t)j * 8 * MiB + 6 * MiB; }
constexpr size_t W_UP2(int i) { return 16 * MiB + (size_t)i * (33 * MiB / 2); }
constexpr size_t W_DN2(int i) { return W_UP2(i) + 11 * MiB; }
constexpr size_t W_RWB(int j) { return 82 * MiB + (size_t)j * 11 * MiB; }
constexpr size_t RW_R = 0, RW_K = 2 * MiB, RW_V = 4 * MiB, RW_O = 6 * MiB, RW_W1 = 8 * MiB, RW_A1 = RW_W1 + 512 * 1024, RW_G1 = RW_A1 + 512 * 1024, RW_V1 = RW_G1 + 512 * 1024,
                 RW_G2 = 10 * MiB, RW_V2 = RW_G2 + 256 * 1024, RW_W2 = RW_V2 + 256 * 1024, RW_A2 = RW_W2 + 256 * 1024;

__device__ __forceinline__ void p0_transpose_item(const TJob& J, LAS float* scr, int item, int lane) {
    const int nblk = J.Ndst / 32, kb = item / nblk, nb = item % nblk, k0 = 64 * kb, n0 = 32 * nb;
    const int n4 = (lane & 7) * 4, n = n0 + n4;
#pragma unroll
    for (int i = 0; i < 8; ++i) { const int kk = 8 * i + (lane >> 3); const int k = k0 + kk;
        f32x4 val = {0.f, 0.f, 0.f, 0.f}; if (k < J.Ksrc && n < J.Nsrc) val = *(const f32x4*)(J.src + (size_t)k * J.Nsrc + n);
        scr[kk * 33 + n4] = val[0]; scr[kk * 33 + n4 + 1] = val[1]; scr[kk * 33 + n4 + 2] = val[2]; scr[kk * 33 + n4 + 3] = val[3]; }
    asm volatile("s_waitcnt lgkmcnt(0)" ::: "memory");
    const int c = lane & 7;
#pragma unroll
    for (int j = 0; j < 4; ++j) { const int nl = (lane >> 3) + 8 * j; const LAS float* s = scr + (8 * c) * 33 + nl;
        u32x4 o; o.x = cvt_pk_bf16(s[0 * 33], s[1 * 33]); o.y = cvt_pk_bf16(s[2 * 33], s[3 * 33]); o.z = cvt_pk_bf16(s[4 * 33], s[5 * 33]); o.w = cvt_pk_bf16(s[6 * 33], s[7 * 33]);
        int nd = n0 + nl;
        if (J.perm == 1 && nd < 2048) { const int s6 = nd & 63, jj = s6 & 31; nd = (nd & ~63) + 8 * (jj >> 2) + (jj & 3) + ((s6 >> 5) << 2); }
        else if (J.perm == 2) { const int isv = nd >= DFF ? 1 : 0, ch = nd - isv * DFF; nd = (ch >> 2) * 8 + isv * 4 + (ch & 3); }
        *(u32x4*)(J.dst + (size_t)nd * J.dld + k0 + 8 * c) = o; }
    asm volatile("s_waitcnt lgkmcnt(0)" ::: "memory");
}

__device__ __forceinline__ void phase_p0(const Params& P, unsigned char* ws, LAS unsigned char* lds) {
    const int tid = tid_(), lane = tid & 63, wave = __builtin_amdgcn_readfirstlane(tid >> 6);
    const int G = gdim_();
    if (bid_() == 0) {
        for (int i = tid; i < 1024; i += NTHR) { const int pos = i >> 4, f = i & 15; const float inv = powf(10000.f, -(float)f / 16.f); const float ang = (float)pos * inv;
            ((f32x2*)(ws + WS_ROPE))[i] = (f32x2){cosf(ang), sinf(ang)}; }
    }
    {
        LAS float* scr = (LAS float*)(lds + wave * 16384);
        const int gw = bid_() * NWAVES + wave, NGW = G * NWAVES;
        int total = 0;
        for (int j = 0; j < P.njobs; ++j) total += (P.jobs[j].Kdst / 64) * (P.jobs[j].Ndst / 32);
        for (int it = gw; it < total; it += NGW) {
            int r = it, j = 0;
            for (; j < P.njobs; ++j) { const int c = (P.jobs[j].Kdst / 64) * (P.jobs[j].Ndst / 32); if (r < c) break; r -= c; }
            p0_transpose_item(P.jobs[j], scr, r, lane);
        }
    }
    __syncthreads();
    {
        LAS float* SV = (LAS float*)lds;
        LAS float* PART = (LAS float*)(lds + 17 * 4096);
        const float* cin = P.in[1]; const float* cctx = P.in[3];
        for (int i = tid; i < 17 * 1024; i += NTHR) { const int j = i >> 10, k = i & 1023; const float x = (j < 16) ? cin[j * 1024 + k] : cctx[k]; SV[i] = x / (1.f + __expf(-x)); }
        __syncthreads();
        for (int item = bid_(); item < NLAYER * 96; item += G) {
            const int l = item / 96, c0 = (item % 96) * 64;
            const float* W = P.in[4] + (size_t)l * 1024 * 6144 + c0 + lane;
            float acc[17];
#pragma unroll
            for (int j = 0; j < 17; ++j) acc[j] = 0.f;
            const int kbeg = wave * 128;
#pragma unroll 2
            for (int k = kbeg; k < kbeg + 128; ++k) { const float w = W[(size_t)k * 6144];
#pragma unroll
                for (int j = 0; j < 17; ++j) acc[j] += SV[j * 1024 + k] * w; }
#pragma unroll
            for (int j = 0; j < 17; ++j) PART[(wave * 17 + j) * 64 + lane] = acc[j];
            __syncthreads();
            for (int o = tid; o < 17 * 64; o += NTHR) { const int j = o >> 6, cc = o & 63; float s = 0.f;
#pragma unroll
                for (int w = 0; w < 8; ++w) s += PART[(w * 17 + j) * 64 + cc];
                ((float*)(ws + WS_MOD))[((size_t)l * 17 + j) * 6144 + c0 + cc] = s + P.in[5][(size_t)l * 6144 + c0 + cc]; }
            __syncthreads();
        }
    }
}

__device__ __forceinline__ size_t xrow_off(int m, bool& isc, int& key) { const int b = m / PB, p = m - b * PB; isc = p < TC; key = isc ? 16 : b; return isc ? ((size_t)(b * TC + p)) * DM : ((size_t)(b * TL + p - TC)) * DM; }
__device__ __forceinline__ void phase_norm_mod(const float* srcL, const float* srcC, float* cpL, float* cpC, const float* g, const float* mod  , int which, bf16_t* H, bf16_t* HB) {
    const int lane = tid_() & 63, wave = tid_() >> 6;
    const int gw = bid_() * NWAVES + wave, NGW = gdim_() * NWAVES;
    const int rpw = (MR + NGW - 1) / NGW; const int m0 = gw * rpw, m1 = (m0 + rpw < MR) ? (m0 + rpw) : MR;
    if (m0 >= m1) return;
    int curkey = -1; f32x4 gm[4], shv[4], v[4], vn[4], vnn[4];
    { bool isc; int key; const size_t ro = xrow_off(m0, isc, key); const f32x4* src = (const f32x4*)((isc ? srcC : srcL) + ro) + lane;
#pragma unroll
      for (int j = 0; j < 4; ++j) v[j] = src[64 * j]; }
    if (m0 + 1 < m1) { bool isc; int key; const size_t ro = xrow_off(m0 + 1, isc, key); const f32x4* src = (const f32x4*)((isc ? srcC : srcL) + ro) + lane;
#pragma unroll
      for (int j = 0; j < 4; ++j) vn[j] = src[64 * j]; }
    for (int m = m0; m < m1; ++m) {
        if (m + 2 < m1) { bool isc2; int key2; const size_t ro2 = xrow_off(m + 2, isc2, key2); const f32x4* src2 = (const f32x4*)((isc2 ? srcC : srcL) + ro2) + lane;
#pragma unroll
            for (int j = 0; j < 4; ++j) vnn[j] = src2[64 * j]; }
        bool isc; int key; const size_t roff = xrow_off(m, isc, key);
        if (key != curkey) { curkey = key; const float* md = mod + (size_t)key * 6144 + which * 3 * DM;
#pragma unroll
            for (int j = 0; j < 4; ++j) { const int c = 4 * lane + 256 * j; const f32x4 gg = *(const f32x4*)(g + c), sc = *(const f32x4*)(md + DM + c); shv[j] = *(const f32x4*)(md + c);
#pragma unroll
                for (int e = 0; e < 4; ++e) gm[j][e] = gg[e] * (1.f + sc[e]); } }
        float ss = 0.f;
#pragma unroll
        for (int j = 0; j < 4; ++j) ss += (v[j][0] * v[j][0] + v[j][1] * v[j][1]) + (v[j][2] * v[j][2] + v[j][3] * v[j][3]);
        const float rstd = rsqrtf(wave_sum(ss) * (1.f / DM) + 1e-6f);
        if (cpL) { f32x4* dst = (f32x4*)((isc ? cpC : cpL) + roff) + lane;
#pragma unroll
            for (int j = 0; j < 4; ++j) dst[64 * j] = v[j]; }
#pragma unroll
        for (int j = 0; j < 4; ++j) { const int c = 4 * lane + 256 * j;
            float o[4];
#pragma unroll
            for (int e = 0; e < 4; ++e) o[e] = v[j][e] * rstd * gm[j][e] + shv[j][e];
            u32x2 w; w.x = cvt_pk_bf16(o[0], o[1]); w.y = cvt_pk_bf16(o[2], o[3]);
            *(u32x2*)(H + (size_t)m * DM + c) = w;
            if (HB) { const int tm = m >> 8, rm = m & 255;
                if (rm == 255) *(u32x2*)(HB + (size_t)(2 * tm) * DM + c) = w;
                else if (rm == 0 && tm > 0) *(u32x2*)(HB + (size_t)(2 * (tm - 1) + 1) * DM + c) = w; } }
#pragma unroll
        for (int j = 0; j < 4; ++j) { v[j] = vn[j]; vn[j] = vnn[j]; }
    }
}
__device__ __forceinline__ void phase_final_norm(float* X, const float* g) {
    const int lane = tid_() & 63, wave = tid_() >> 6;
    const int gw = bid_() * NWAVES + wave, NGW = gdim_() * NWAVES;
    const int NR = NB * TL; const int rpw = (NR + NGW - 1) / NGW; const int m0 = gw * rpw, m1 = (m0 + rpw < NR) ? (m0 + rpw) : NR;
    if (m0 >= m1) return;
    f32x4 gg[4], v[4], vn[4];
#pragma unroll
    for (int j = 0; j < 4; ++j) { gg[j] = *(const f32x4*)(g + 4 * lane + 256 * j); v[j] = ((const f32x4*)(X + (size_t)m0 * DM) + lane)[64 * j]; }
    for (int m = m0; m < m1; ++m) {
        if (m + 1 < m1) { const f32x4* s2 = (const f32x4*)(X + (size_t)(m + 1) * DM) + lane;
#pragma unroll
            for (int j = 0; j < 4; ++j) vn[j] = s2[64 * j]; }
        float ss = 0.f;
#pragma unroll
        for (int j = 0; j < 4; ++j) ss += (v[j][0] * v[j][0] + v[j][1] * v[j][1]) + (v[j][2] * v[j][2] + v[j][3] * v[j][3]);
        const float rstd = rsqrtf(wave_sum(ss) * (1.f / DM) + 1e-6f);
        f32x4* dst = (f32x4*)(X + (size_t)m * DM) + lane;
#pragma unroll
        for (int j = 0; j < 4; ++j) { f32x4 o;
#pragma unroll
            for (int e = 0; e < 4; ++e) o[e] = v[j][e] * rstd * gg[j][e];
            dst[64 * j] = o; }
#pragma unroll
        for (int j = 0; j < 4; ++j) v[j] = vn[j];
    }
}
__device__ __forceinline__ void phase_mix(const bf16_t* H, const float* mp, const float* mn, int ma, int mb, bf16_t* OA, bf16_t* OB, const bf16_t* Kt, const float* kk_w, float* KN) {
    const int lane = tid_() & 63, wave = tid_() >> 6;
    const int gw = bid_() * NWAVES + wave, NGW = gdim_() * NWAVES;
    const int rpw = (MR + NGW - 1) / NGW; const int m0 = gw * rpw, m1 = (m0 + rpw < MR) ? (m0 + rpw) : MR;
    if (m0 >= m1) return;
    const int c0 = lane * 16;
    float pa[16], na[16], pb[16], nb[16];
#pragma unroll
    for (int i = 0; i < 16; ++i) { pa[i] = mp[ma * DM + c0 + i]; na[i] = mn[ma * DM + c0 + i]; pb[i] = mp[mb * DM + c0 + i]; nb[i] = mn[mb * DM + c0 + i]; }
    float kw[16];
#pragma unroll
    for (int i = 0; i < 16; ++i) kw[i] = KN ? kk_w[c0 + i] : 0.f;
    const u32x4 z4 = {0u, 0u, 0u, 0u};
    u32x4 P0 = z4, P1 = z4, C0, C1, N0 = z4, N1 = z4, NN0 = z4, NN1 = z4, K0 = z4, K1 = z4, KN0 = z4, KN1 = z4;
    { const u32x4* q = (const u32x4*)(H + (size_t)m0 * DM + c0); C0 = q[0]; C1 = q[1]; }
    if (m0 > 0) { const u32x4* q = (const u32x4*)(H + (size_t)(m0 - 1) * DM + c0); P0 = q[0]; P1 = q[1]; }
    if (m0 + 1 < MR) { const u32x4* q = (const u32x4*)(H + (size_t)(m0 + 1) * DM + c0); N0 = q[0]; N1 = q[1]; }
    if (KN) { const u32x4* kr = (const u32x4*)(Kt + (size_t)m0 * DM + c0); K0 = kr[0]; K1 = kr[1]; }
    for (int m = m0; m < m1; ++m) {
        if (m + 2 < MR && m + 1 < m1) { const u32x4* q = (const u32x4*)(H + (size_t)(m + 2) * DM + c0); NN0 = q[0]; NN1 = q[1]; }
        if (KN && m + 1 < m1) { const u32x4* kr = (const u32x4*)(Kt + (size_t)(m + 1) * DM + c0); KN0 = kr[0]; KN1 = kr[1]; }
        const int b = m / PB, p = m - b * PB;
        const bool first = (p == 0) || (p == TC), lastr = (p == TC - 1) || (p == PB - 1);
        float h[16], hp[16], hn[16];
        unpack8(C0, h); unpack8(C1, h + 8);
        unpack8(first ? z4 : P0, hp); unpack8(first ? z4 : P1, hp + 8);
        unpack8(lastr ? z4 : N0, hn); unpack8(lastr ? z4 : N1, hn + 8);
        float oa[16], ob[16];
#pragma unroll
        for (int i = 0; i < 16; ++i) { const float dp = hp[i] - h[i], dn = hn[i] - h[i];
            oa[i] = h[i] + dp * pa[i] + dn * na[i];
            ob[i] = h[i] + dp * pb[i] + dn * nb[i]; }
        u32x4* da = (u32x4*)(OA + (size_t)m * DM + c0); da[0] = pack8(oa); da[1] = pack8(oa + 8);
        u32x4* db = (u32x4*)(OB + (size_t)m * DM + c0); db[0] = pack8(ob); db[1] = pack8(ob + 8);
        if (KN) {
            float kv[16]; unpack8(K0, kv); unpack8(K1, kv + 8);
            float ss = 0.f;
#pragma unroll
            for (int i = 0; i < 16; ++i) { const float t = kv[i] * kw[i]; ss += t * t; }
            ss = red4(ss);
            if ((lane & 3) == 0) KN[(size_t)m * 16 + (lane >> 2)] = 1.f / fmaxf(sqrtf(ss), 1e-12f);
        }
        P0 = C0; P1 = C1; C0 = N0; C1 = N1; N0 = NN0; N1 = NN1; K0 = KN0; K1 = KN1;
    }
}
__device__ __forceinline__ void phase_convact(const bf16_t* GV, bf16_t* ACT, int rows, int row_off, const float* cw, const float* cb) {
    const size_t nitem = (size_t)rows * 352;
    for (size_t it = (size_t)bid_() * NTHR + tid_(); it < nitem; it += (size_t)gdim_() * NTHR) {
        const int r = (int)(it / 352), cg8 = (int)(it - (size_t)r * 352), n0 = cg8 * 8;
        const int gr = r + row_off; const int b = gr / PB, p = gr - b * PB;
        const bool first = (p == 0) || (p == TC), lastr = (p == TC - 1) || (p == PB - 1);
        const bf16_t* base = GV + (size_t)r * 5632 + n0;
        float g[8], gp[8], gn[8], vv[8];
        unpack8(*(const u32x4*)base, g); unpack8(*(const u32x4*)(base + DFF), vv);
        if (!first) unpack8(*(const u32x4*)(base - 5632), gp); else { for (int i = 0; i < 8; ++i) gp[i] = 0.f; }
        if (!lastr) unpack8(*(const u32x4*)(base + 5632), gn); else { for (int i = 0; i < 8; ++i) gn[i] = 0.f; }
        float o[8];
#pragma unroll
        for (int i = 0; i < 8; ++i) { const float x = gp[i] * cw[n0 + i] + g[i] * cw[DFF + n0 + i] + gn[i] * cw[2 * DFF + n0 + i] + cb[n0 + i];
            o[i] = x / (1.f + __expf(-x)) * vv[i]; }
        *(u32x4*)(ACT + (size_t)r * DFF + n0) = pack8(o);
    }
}
__device__ __forceinline__ void phase_post(const bf16_t* Y0, const bf16_t* Y1, const bf16_t* V, const float* CB, const float* lg, const float* lb, bf16_t* Z) {
    const int lane = tid_() & 63, wave = tid_() >> 6;
    const int gw = bid_() * NWAVES + wave, NGW = gdim_() * NWAVES;
    const int rpw = (MR + NGW - 1) / NGW; const int m0 = gw * rpw, m1 = (m0 + rpw < MR) ? (m0 + rpw) : MR;
    const int c0 = lane * 16, hd = lane >> 2;
    float lgv[16], lbv[16];
#pragma unroll
    for (int i = 0; i < 16; ++i) { lgv[i] = lg[c0 + i]; lbv[i] = lb[c0 + i]; }
    if (m0 >= m1) return;
    u32x4 ya0, ya1, yb0, yb1, vv0, vv1, na0, na1, nb0, nb1, nv0, nv1;
    { const u32x4* q = (const u32x4*)(Y0 + (size_t)m0 * DM + c0); ya0 = q[0]; ya1 = q[1]; q = (const u32x4*)(Y1 + (size_t)m0 * DM + c0); yb0 = q[0]; yb1 = q[1]; q = (const u32x4*)(V + (size_t)m0 * DM + c0); vv0 = q[0]; vv1 = q[1]; }
    na0 = ya0; na1 = ya1; nb0 = yb0; nb1 = yb1; nv0 = vv0; nv1 = vv1;
    for (int m = m0; m < m1; ++m) {
        if (m + 1 < m1) { const u32x4* q = (const u32x4*)(Y0 + (size_t)(m + 1) * DM + c0); na0 = q[0]; na1 = q[1]; q = (const u32x4*)(Y1 + (size_t)(m + 1) * DM + c0); nb0 = q[0]; nb1 = q[1]; q = (const u32x4*)(V + (size_t)(m + 1) * DM + c0); nv0 = q[0]; nv1 = q[1]; }
        float a[16], b2[16], vv[16];
        unpack8(ya0, a); unpack8(ya1, a + 8); unpack8(yb0, b2); unpack8(yb1, b2 + 8); unpack8(vv0, vv); unpack8(vv1, vv + 8);
        ya0 = na0; ya1 = na1; yb0 = nb0; yb1 = nb1; vv0 = nv0; vv1 = nv1;
        float s = 0.f;
#pragma unroll
        for (int i = 0; i < 16; ++i) { a[i] += b2[i]; s += a[i]; }
        s = red4(s); const float mu = s * (1.f / 64.f); float q2 = 0.f;
#pragma unroll
        for (int i = 0; i < 16; ++i) { a[i] -= mu; q2 += a[i] * a[i]; }
        q2 = red4(q2); const float rs = rsqrtf(q2 * (1.f / 64.f) + 64e-5f);
        const float bon = CB[(size_t)m * 16 + hd] + CB[(size_t)MR * 16 + (size_t)m * 16 + hd];
        float o[16];
#pragma unroll
        for (int i = 0; i < 16; ++i) o[i] = a[i] * rs * lgv[i] + lbv[i] + bon * vv[i];
        u32x4* d = (u32x4*)(Z + (size_t)m * DM + c0); d[0] = pack8(o); d[1] = pack8(o + 8);
    }
}

namespace att {
constexpr int KVBLK = 64, LD = 1024;
constexpr float SCALE = 0.125f;
constexpr float THR = 8.f;
constexpr size_t SHM_V = KVBLK * 128 * 2, SHM_K = KVBLK * 128 * 2;
#define KSWZ(row, colB) ((row) * 256 + ((colB) ^ (((row) & 7) << 4)))
#define SBAR() __builtin_amdgcn_sched_barrier(0)
__device__ __forceinline__ int crow(int r, int hi) { return (r & 3) + 8 * (r >> 2) + 4 * hi; }
__device__ __forceinline__ void partialSM(f32x16& p0, f32x16& p1, float& m_reg, float& mn, float& alpha) {
    constexpr float C = SCALE * 1.4426950408889634f;
    float pmax = p0[0];
#pragma unroll
    for (int r = 1; r < 16; ++r) pmax = fmaxf(pmax, p0[r]);
#pragma unroll
    for (int r = 0; r < 16; ++r) pmax = fmaxf(pmax, p1[r]);
    { auto rr = __builtin_amdgcn_permlane32_swap(__float_as_uint(pmax), __float_as_uint(pmax), false, false);
      pmax = fmaxf(__uint_as_float(rr[0]), __uint_as_float(rr[1])); }
    if (__builtin_expect(__all(pmax - m_reg <= THR / SCALE), 1)) { mn = m_reg; alpha = 1.f; }
    else { mn = fmaxf(m_reg, pmax); alpha = __builtin_amdgcn_exp2f((m_reg - mn) * C); m_reg = mn; }
    const float mnC = -mn * C;
#pragma unroll
    for (int r = 0; r < 16; ++r) p0[r] = fmaf(p0[r], C, mnC);
#pragma unroll
    for (int r = 0; r < 16; ++r) p1[r] = fmaf(p1[r], C, mnC);
#pragma unroll
    for (int r = 0; r < 16; ++r) p0[r] = __builtin_amdgcn_exp2f(p0[r]);
}
__device__ __forceinline__ void finishSM(f32x16& p0, f32x16& p1, float alpha, float& l_reg, bf16x8& pa0, bf16x8& pa1, bf16x8& pa2, bf16x8& pa3) {
#pragma unroll
    for (int r = 0; r < 16; ++r) p1[r] = __builtin_amdgcn_exp2f(p1[r]);
    float ps = 0;
#pragma unroll
    for (int r = 0; r < 16; ++r) ps += p0[r];
#pragma unroll
    for (int r = 0; r < 16; ++r) ps += p1[r];
    { auto rr = __builtin_amdgcn_permlane32_swap(__float_as_uint(ps), __float_as_uint(ps), false, false);
      ps = __uint_as_float(rr[0]) + __uint_as_float(rr[1]); }
    l_reg = l_reg * alpha + ps;
#define PK4(P, BASE, OUT) do { unsigned a0 = cvt_pk_bf16(P[BASE + 0], P[BASE + 1]), a1 = cvt_pk_bf16(P[BASE + 2], P[BASE + 3]);   \
    unsigned b0 = cvt_pk_bf16(P[BASE + 4], P[BASE + 5]), b1 = cvt_pk_bf16(P[BASE + 6], P[BASE + 7]);                              \
    auto r0 = __builtin_amdgcn_permlane32_swap(a0, b0, false, false); auto r1 = __builtin_amdgcn_permlane32_swap(a1, b1, false, false); \
    u32x4 w = {r0[0], r1[0], r0[1], r1[1]}; OUT = *reinterpret_cast<bf16x8*>(&w); } while (0)
    PK4(p0, 0, pa0); PK4(p0, 8, pa1); PK4(p1, 0, pa2); PK4(p1, 8, pa3);
#undef PK4
}
__device__ __forceinline__ void qkt(f32x16& p0, f32x16& p1, const char* Ks, const bf16x8* qr, int r32, int hi, int comp) {
    p0 = f32x16{}; p1 = f32x16{};
#pragma unroll
    for (int d0 = 0; d0 < 4; ++d0) { const int cb = (comp * 64 + d0 * 16 + hi * 8) * 2;
        const bf16x8 b0 = *reinterpret_cast<const bf16x8*>(Ks + KSWZ(r32, cb));
        const bf16x8 b1 = *reinterpret_cast<const bf16x8*>(Ks + KSWZ(32 + r32, cb));
        p0 = __builtin_amdgcn_mfma_f32_32x32x16_bf16(b0, qr[d0], p0, 0, 0, 0);
        p1 = __builtin_amdgcn_mfma_f32_32x32x16_bf16(b1, qr[d0], p1, 0, 0, 0); }
}
__device__ __forceinline__ int v_st(int k, int c) { const int kk = (k & ~0xC) | ((k & 4) << 1) | ((k & 8) >> 1); return ((kk >> 3) * 4 + (c >> 5)) * 512 + ((kk & 7) * 32 + (c & 31)) * 2; }
__device__ __forceinline__ int v_rd_base(int lane) { return ((lane & 3) << 3) | (((lane >> 2) & 3) << 6) | (((lane >> 4) & 1) << 5) | (((lane >> 5) & 1) << 8); }
constexpr int v_rd_off(int d0, int ks, int half) { return d0 * 512 + ks * 4096 + half * 2048; }
template <int OFF> __device__ __forceinline__ s16x4 tr_read(int vb) {
    s16x4 r; asm volatile("ds_read_b64_tr_b16 %0, %1 offset:%2" : "=&v"(r) : "v"(vb), "i"(OFF) : "memory"); return r;
}
template <int D0> __device__ __forceinline__ void pv_one(f32x16& od, int vb, bf16x8 pa0, bf16x8 pa1, bf16x8 pa2, bf16x8 pa3) {
    const s16x4 l0 = tr_read<v_rd_off(D0, 0, 0)>(vb), h0 = tr_read<v_rd_off(D0, 0, 1)>(vb), l1 = tr_read<v_rd_off(D0, 1, 0)>(vb), h1 = tr_read<v_rd_off(D0, 1, 1)>(vb);
    const s16x4 l2 = tr_read<v_rd_off(D0, 2, 0)>(vb), h2 = tr_read<v_rd_off(D0, 2, 1)>(vb), l3 = tr_read<v_rd_off(D0, 3, 0)>(vb), h3 = tr_read<v_rd_off(D0, 3, 1)>(vb);
    asm volatile("s_waitcnt lgkmcnt(0)" ::: "memory"); SBAR();
#define PK(L, H) (bf16x8){L[0], L[1], L[2], L[3], H[0], H[1], H[2], H[3]}
    od = __builtin_amdgcn_mfma_f32_32x32x16_bf16(pa0, PK(l0, h0), od, 0, 0, 0);
    od = __builtin_amdgcn_mfma_f32_32x32x16_bf16(pa1, PK(l1, h1), od, 0, 0, 0);
    od = __builtin_amdgcn_mfma_f32_32x32x16_bf16(pa2, PK(l2, h2), od, 0, 0, 0);
    od = __builtin_amdgcn_mfma_f32_32x32x16_bf16(pa3, PK(l3, h3), od, 0, 0, 0);
#undef PK
}
__device__ __forceinline__ void pv_d0(f32x16* o, int vb, bf16x8 pa0, bf16x8 pa1, bf16x8 pa2, bf16x8 pa3) {
    pv_one<0>(o[0], vb, pa0, pa1, pa2, pa3); pv_one<1>(o[1], vb, pa0, pa1, pa2, pa3); pv_one<2>(o[2], vb, pa0, pa1, pa2, pa3); pv_one<3>(o[3], vb, pa0, pa1, pa2, pa3);
}
__device__ __forceinline__ void attn_unit(const bf16_t* Qb, const bf16_t* Kh, const bf16_t* Vh, bf16_t* Ob, float* scr, int seq, float lam, float onemli, const float* subg, char* lds) {
    const int tid = tid_(), wid = tid >> 6, lane = tid & 63, r32 = lane & 31, hi = lane >> 5;
    char* V_lds = lds; char* K_lds = lds + 2 * SHM_V;
    float* wsl = (float*)(lds + 2 * SHM_V + 2 * SHM_K) + wid * 64; float* li_l = wsl; float* al_l = wsl + 32;
    const int sr = tid >> 4, sc = (tid & 15) * 8, vst0 = v_st(sr, sc), vst1 = v_st(32 + sr, sc);
    const unsigned kvoff = (unsigned)(sr * LD + sc) * 2u;
    const int vb0 = (int)(uintptr_t)V_lds + v_rd_base(lane);
    const int NT = seq / KVBLK;
#pragma unroll
    for (int comp = 0; comp < 2; ++comp) {
        float m_reg = -1e30f, l_reg = 0; f32x16 o[4] = {}; bf16x8 qr[4];
        const unsigned qoff = (unsigned)((wid * 32 + r32) * LD + comp * 64 + hi * 8) * 2u;
#pragma unroll
        for (int d0 = 0; d0 < 4; ++d0) qr[d0] = *reinterpret_cast<const bf16x8*>((const char*)Qb + qoff + d0 * 32);
        struct { bf16x8 vs0, vs1, ks0, ks1; } sr_[1];
#define SLOAD(i, k0) do { const unsigned o0_ = kvoff + (unsigned)(k0) * (LD * 2), o1_ = o0_ + 32 * LD * 2; \
    sr_[i].vs0 = *reinterpret_cast<const bf16x8*>((const char*)Vh + o0_); sr_[i].vs1 = *reinterpret_cast<const bf16x8*>((const char*)Vh + o1_); \
    sr_[i].ks0 = *reinterpret_cast<const bf16x8*>((const char*)Kh + o0_); sr_[i].ks1 = *reinterpret_cast<const bf16x8*>((const char*)Kh + o1_); } while (0)
#define SWRITE(b, i) do { *(bf16x8*)(V_lds + (b) * SHM_V + vst0) = sr_[i].vs0;          \
    *(bf16x8*)(V_lds + (b) * SHM_V + vst1) = sr_[i].vs1; int kc = sc * 2;               \
    *(bf16x8*)(K_lds + (b) * SHM_K + KSWZ(sr, kc)) = sr_[i].ks0;                       \
    *(bf16x8*)(K_lds + (b) * SHM_K + KSWZ(32 + sr, kc)) = sr_[i].ks1; } while (0)
#define SWAIT() asm volatile("s_waitcnt vmcnt(0)" ::: "memory")
#define RESC(a) do { if (__any((a) < 1.f)) { if (hi == 0) al_l[r32] = (a); asm volatile("s_waitcnt lgkmcnt(0)" ::: "memory"); \
    _Pragma("unroll") for (int d = 0; d < 4; ++d) _Pragma("unroll") for (int r = 0; r < 16; ++r) o[d][r] *= al_l[crow(r, hi)]; } } while (0)
        f32x16 pA0, pA1, pB0, pB1; float mnA, mnB, alA, alB; bf16x8 pa0, pa1, pa2, pa3;
        constexpr int SE = 0, SO = 0;
        SLOAD(SE, 0); asm volatile("s_waitcnt vmcnt(0)" ::: "memory"); SWRITE(0, SE); __syncthreads();
        qkt(pA0, pA1, K_lds, qr, r32, hi, comp); partialSM(pA0, pA1, m_reg, mnA, alA);
        SLOAD(SO, KVBLK);
        SWAIT(); SWRITE(1, SO); __syncthreads();
        for (int j = 1; j + 1 < NT; j += 2) {
            SBAR(); qkt(pB0, pB1, K_lds + SHM_K, qr, r32, hi, comp);
            finishSM(pA0, pA1, alA, l_reg, pa0, pa1, pa2, pa3); SBAR();
            SLOAD(SO, (j + 1) * KVBLK); SBAR();
            pv_d0(o, vb0, pa0, pa1, pa2, pa3); partialSM(pB0, pB1, m_reg, mnB, alB);
            __syncthreads(); SWAIT(); SWRITE(0, SE);
            RESC(alB); __syncthreads();
            SBAR(); qkt(pA0, pA1, K_lds, qr, r32, hi, comp);
            finishSM(pB0, pB1, alB, l_reg, pa0, pa1, pa2, pa3); SBAR();
            SLOAD(SE, (j + 2) * KVBLK); SBAR();
            pv_d0(o, vb0 + (int)SHM_V, pa0, pa1, pa2, pa3); partialSM(pA0, pA1, m_reg, mnA, alA);
            __syncthreads(); SWAIT(); SWRITE(1, SO);
            RESC(alA); __syncthreads();
        }
        SBAR(); qkt(pB0, pB1, K_lds + SHM_K, qr, r32, hi, comp);
        finishSM(pA0, pA1, alA, l_reg, pa0, pa1, pa2, pa3); SBAR();
        pv_d0(o, vb0, pa0, pa1, pa2, pa3); partialSM(pB0, pB1, m_reg, mnB, alB);
        __syncthreads(); RESC(alB);
        finishSM(pB0, pB1, alB, l_reg, pa0, pa1, pa2, pa3); SBAR();
        pv_d0(o, vb0 + (int)SHM_V, pa0, pa1, pa2, pa3);
        if (hi == 0) li_l[r32] = l_reg; asm volatile("s_waitcnt lgkmcnt(0)" ::: "memory");
        float rli[16];
#pragma unroll
        for (int r = 0; r < 16; ++r) rli[r] = __builtin_amdgcn_rcpf(li_l[crow(r, hi)]);
        unsigned soff = (unsigned)((wid * 64 + lane) * 256); asm volatile("" : "+v"(soff));
        f32x4* sw = (f32x4*)((char*)scr + soff);
        if (comp == 0) {
#pragma unroll
            for (int d0 = 0; d0 < 4; ++d0)
#pragma unroll
                for (int r = 0; r < 16; r += 4) sw[d0 * 4 + (r >> 2)] = (f32x4){o[d0][r] * rli[r], o[d0][r + 1] * rli[r + 1], o[d0][r + 2] * rli[r + 2], o[d0][r + 3] * rli[r + 3]};
        } else {
            float ssq[16];
#pragma unroll
            for (int r = 0; r < 16; ++r) ssq[r] = 0.f;
#pragma unroll
            for (int d0 = 0; d0 < 4; ++d0) {
#pragma unroll
                for (int r4 = 0; r4 < 4; ++r4) { const f32x4 pv = sw[d0 * 4 + r4];
#pragma unroll
                    for (int e = 0; e < 4; ++e) { const int r = r4 * 4 + e; const float x = pv[e] - lam * (o[d0][r] * rli[r]); o[d0][r] = x; ssq[r] += x * x; } }
                asm volatile("" ::: "memory");
            }
#pragma unroll
            for (int r = 0; r < 16; ++r) {
                float s = ssq[r];
                s += __shfl_xor(s, 1); s += __shfl_xor(s, 2); s += __shfl_xor(s, 4); s += __shfl_xor(s, 8); s += __shfl_xor(s, 16);
                ssq[r] = rsqrtf(s * (1.f / 128.f) + 1e-6f) * onemli;
            }
            float sg[4];
#pragma unroll
            for (int d0 = 0; d0 < 4; ++d0) sg[d0] = subg[d0 * 32 + r32];
            char* stg = lds + 67584 + wid * 8704;
            unsigned sbase = (unsigned)((4 * hi) * 272 + r32 * 2); asm volatile("" : "+v"(sbase));
#pragma unroll
            for (int r = 0; r < 16; ++r) { const int orow = (r & 3) + 8 * (r >> 2);
#pragma unroll
                for (int d0 = 0; d0 < 4; ++d0) { const unsigned w = cvt_pk_bf16(o[d0][r] * ssq[r] * sg[d0], 0.f); *(bf16_t*)(stg + sbase + orow * 272 + d0 * 64) = (bf16_t)(w & 0xffffu); } }
            asm volatile("s_waitcnt lgkmcnt(0)" ::: "memory");
            unsigned rdo = (unsigned)((lane >> 4) * 272 + (lane & 15) * 16); asm volatile("" : "+v"(rdo));
            unsigned gwo = (unsigned)(((wid * 32 + (lane >> 4)) * LD + (lane & 15) * 8) * 2); asm volatile("" : "+v"(gwo));
#pragma unroll
            for (int it = 0; it < 8; ++it) { const u32x4 w = *(const u32x4*)(stg + rdo + it * 4 * 272); *(u32x4*)((char*)Ob + gwo + it * 4 * LD * 2) = w; }
            asm volatile("s_waitcnt lgkmcnt(0)" ::: "memory");
        }
#undef SLOAD
#undef SWRITE
#undef SWAIT
#undef RESC
    }
}
}

__device__ __forceinline__ void phase_attn(const bf16_t* Q, const bf16_t* K, const bf16_t* V, bf16_t* O, float* scr_all, const float* lamv, float lambda_init, const float* subg, char* lds) {
    float s01 = 0.f, s23 = 0.f;
    for (int i = 0; i < 64; ++i) { s01 += lamv[i] * lamv[64 + i]; s23 += lamv[128 + i] * lamv[192 + i]; }
    const float lam = __expf(s01) - __expf(s23) + lambda_init;
    const float onemli = 1.f - lambda_init;
    float* scr = scr_all + (size_t)bid_() * 32768;
    const int G = gdim_(), blk = bid_();
    const int NU = NB * 8 * 16 + NB * 8;
    for (int i = 0;; ++i) {
        int u = i * G + blk; if (u >= NU) break;
        int pair, qb; bool isctx = false;
        if (u < 2048) {
            if (G == 256) { const int x = blk & 7, vb = blk >> 3; pair = i * 16 + 2 * x + (vb >> 4); qb = vb & 15; }
            else { pair = u >> 4; qb = u & 15; }
        } else { pair = u - 2048; qb = 0; isctx = true; }
        const int b = pair >> 3, h = pair & 7;
        const size_t rb = (size_t)b * PB;
        const size_t qrow = rb + (isctx ? 0 : (TC + qb * 256));
        att::attn_unit(Q + qrow * DM + h * 128, K + rb * DM + h * 128, V + rb * DM + h * 128, O + qrow * DM + h * 128, scr, isctx ? TC : PB, lam, onemli, subg, lds);
    }
}

struct ScanArgs { const bf16_t *R, *K, *V, *WL, *AL; const float* KN; const bf16_t *W2T, *A2T; const float *w0, *a0, *k_k, *k_a, *r_k; bf16_t *Y0, *Y1; float* CB; };
__device__ __forceinline__ int scan_row(int dir, int s) { return dir == 0 ? s : (s < TC ? (TC - 1 - s) : (PB + TC - 1 - s)); }

struct ScanRaw { bf16x8 aw[2], aa[2]; unsigned kv[2][4], rv[2][4], vv[2][4]; float knv[4]; };
__device__ __forceinline__ void scan_issue(const ScanArgs& A, int dir, int b, int h, int nbh, int chunk, int lane, ScanRaw& R) {
    const int kq = lane >> 4, l16 = lane & 15;
    const int s0 = chunk * 16;
    const size_t mA = (size_t)b * PB + scan_row(dir, s0 + l16);
#pragma unroll
    for (int ks = 0; ks < 2; ++ks) { R.aw[ks] = *(const bf16x8*)(A.WL + mA * 128 + dir * 64 + ks * 32 + kq * 8); R.aa[ks] = *(const bf16x8*)(A.AL + mA * 128 + dir * 64 + ks * 32 + kq * 8); }
#pragma unroll
    for (int i = 0; i < 4; ++i) { const unsigned mrow = (unsigned)(b * PB + scan_row(dir, s0 + kq * 4 + i)); R.knv[i] = A.KN[(size_t)mrow * 16 + h];
#pragma unroll
        for (int nb2 = 0; nb2 < 2; ++nb2) { const int n = (nbh * 2 + nb2) * 16 + l16; const unsigned g = (mrow * DM + h * 64 + n) * 2u;
            R.kv[nb2][i] = *(const bf16_t*)((const char*)A.K + g); R.rv[nb2][i] = *(const bf16_t*)((const char*)A.R + g); R.vv[nb2][i] = *(const bf16_t*)((const char*)A.V + g); } }
}
__device__ __forceinline__ void scan_process(const ScanRaw& R, int nbh, LAS float* IN, LAS float* BON, int lane,
                                             const bf16x8 (&w2b)[2][2], const bf16x8 (&a2b)[2][2], const float (&w0v)[2], const float (&a0v)[2], const float (&kkv)[2], const float (&kav)[2], const float (&rkv)[2]) {
    const int kq = lane >> 4, l16 = lane & 15;
    float bon[4] = {0.f, 0.f, 0.f, 0.f};
#pragma unroll
    for (int nb2 = 0; nb2 < 2; ++nb2) {
        const int nb = nbh * 2 + nb2; const int n = nb * 16 + l16;
        f32x4 accw = {0.f, 0.f, 0.f, 0.f}, acca = {0.f, 0.f, 0.f, 0.f};
        accw = __builtin_amdgcn_mfma_f32_16x16x32_bf16(R.aw[0], w2b[0][nb2], accw, 0, 0, 0);
        accw = __builtin_amdgcn_mfma_f32_16x16x32_bf16(R.aw[1], w2b[1][nb2], accw, 0, 0, 0);
        acca = __builtin_amdgcn_mfma_f32_16x16x32_bf16(R.aa[0], a2b[0][nb2], acca, 0, 0, 0);
        acca = __builtin_amdgcn_mfma_f32_16x16x32_bf16(R.aa[1], a2b[1][nb2], acca, 0, 0, 0);
#pragma unroll
        for (int i = 0; i < 4; ++i) {
            const int tp = kq * 4 + i;
            const float kv = __uint_as_float(R.kv[nb2][i] << 16), rv = __uint_as_float(R.rv[nb2][i] << 16), vv = __uint_as_float(R.vv[nb2][i] << 16);
            const float win = w0v[nb2] + accw[i];
            const float decay = __expf(-0.6065306597126334f * sigmoidf_(win));
            const float a = sigmoidf_(a0v[nb2] + acca[i]);
            const float kk = kv * kkv[nb2] * R.knv[i];
            const float kd = kv * (1.f + (a - 1.f) * kav[nb2]);
            bon[i] += rv * kd * rkv[nb2];
            LAS float* d = IN + tp * 64 + n;
            d[0 * 1024] = decay; d[1 * 1024] = kd; d[2 * 1024] = kk * a; d[3 * 1024] = -kk; d[4 * 1024] = rv; d[5 * 1024] = vv;
        }
    }
#pragma unroll
    for (int i = 0; i < 4; ++i) { const float s = red16(bon[i]); if (l16 == 0) BON[nbh * 16 + kq * 4 + i] = s; }
}

__device__ __forceinline__ void phase_scan(const ScanArgs A, LAS unsigned char* lds) {
    const int tid = tid_(), lane = tid & 63, wave = __builtin_amdgcn_readfirstlane(tid >> 6);
    constexpr int NCH = PB / 16;
    for (int cp = bid_(); cp < 256; cp += gdim_()) {
        const int dir = cp >> 7, rem = cp & 127, b = rem >> 3, h0 = (rem & 7) * 2;
        const bool consumer = wave < 4;
        const int chain = consumer ? (wave >> 1) : ((wave - 4) >> 1);
        const int half = wave & 1;
        const int h = h0 + chain;
        LAS float* INc = (LAS float*)(lds + chain * 49152);
        LAS float* YBc = (LAS float*)(lds + 98304 + chain * 8192);
        LAS float* BONc = (LAS float*)(lds + 114688 + chain * 512);
        bf16_t* Yd = dir == 0 ? A.Y0 : A.Y1;
        bf16x8 w2b[2][2], a2b[2][2]; float w0v[2], a0v[2], kkv[2], kav[2], rkv[2];
        if (!consumer) {
            const int kq = lane >> 4, l16 = lane & 15;
#pragma unroll
            for (int nb2 = 0; nb2 < 2; ++nb2) { const int n = h * 64 + (half * 2 + nb2) * 16 + l16;
#pragma unroll
                for (int ks = 0; ks < 2; ++ks) { w2b[ks][nb2] = *(const bf16x8*)(A.W2T + ((size_t)dir * DM + n) * 64 + ks * 32 + kq * 8); a2b[ks][nb2] = *(const bf16x8*)(A.A2T + ((size_t)dir * DM + n) * 64 + ks * 32 + kq * 8); }
                w0v[nb2] = A.w0[dir * DM + n]; a0v[nb2] = A.a0[dir * DM + n]; kkv[nb2] = A.k_k[n]; kav[nb2] = A.k_a[n]; rkv[nb2] = A.r_k[n]; }
        }
        f32x2 S2[2][8];
#pragma unroll
        for (int i = 0; i < 2; ++i)
#pragma unroll
            for (int p = 0; p < 8; ++p) S2[i][p] = (f32x2){0.f, 0.f};
        const int rb = lane >> 2, kq = lane & 3;
        __syncthreads();
        ScanRaw RW_;
        if (!consumer) { scan_issue(A, dir, b, h, half, 0, lane, RW_); scan_process(RW_, half, INc, BONc, lane, w2b, a2b, w0v, a0v, kkv, kav, rkv); scan_issue(A, dir, b, h, half, 1, lane, RW_); }
        __syncthreads();
        for (int c = 0; c < NCH; ++c) {
            if (consumer) {
                const LAS float* in = INc + (c & 1) * 6144;
                LAS float* yb = YBc + (c & 1) * 1024;
#pragma unroll 2
                for (int t = 0; t < 16; ++t) {
                    const LAS float* q = in + t * 64 + kq * 16;
                    f32x4 Wv[4], KDv[4], Bv[4], ANv[4], Rv[4];
#pragma unroll
                    for (int j = 0; j < 4; ++j) { Wv[j] = *(const LAS f32x4*)(q + 4 * j); KDv[j] = *(const LAS f32x4*)(q + 1024 + 4 * j); Bv[j] = *(const LAS f32x4*)(q + 2048 + 4 * j);
                                                  ANv[j] = *(const LAS f32x4*)(q + 3072 + 4 * j); Rv[j] = *(const LAS f32x4*)(q + 4096 + 4 * j); }
                    const f32x2 v2 = *(const LAS f32x2*)(in + 5120 + t * 64 + half * 32 + rb * 2);
#define PAIR(V, p) ((f32x2){V[(p) >> 1][((p) & 1) * 2], V[(p) >> 1][((p) & 1) * 2 + 1]})
                    float sa[2], y[2];
#pragma unroll
                    for (int i = 0; i < 2; ++i) { f32x2 a0 = {0.f, 0.f}, a1 = {0.f, 0.f};
#pragma unroll
                        for (int p = 0; p < 8; p += 2) { a0 += S2[i][p] * PAIR(ANv, p); a1 += S2[i][p + 1] * PAIR(ANv, p + 1); }
                        a0 += a1; sa[i] = red4(a0[0] + a0[1]); }
#pragma unroll
                    for (int i = 0; i < 2; ++i) { f32x2 y0 = {0.f, 0.f}, y1 = {0.f, 0.f}; const f32x2 sai = {sa[i], sa[i]}, vi = {v2[i], v2[i]};
#pragma unroll
                        for (int p = 0; p < 8; p += 2) {
                            const f32x2 n0 = S2[i][p] * PAIR(Wv, p) + sai * PAIR(Bv, p) + vi * PAIR(KDv, p);
                            const f32x2 n1 = S2[i][p + 1] * PAIR(Wv, p + 1) + sai * PAIR(Bv, p + 1) + vi * PAIR(KDv, p + 1);
                            S2[i][p] = n0; S2[i][p + 1] = n1; y0 += n0 * PAIR(Rv, p); y1 += n1 * PAIR(Rv, p + 1); }
                        y0 += y1; y[i] = red4(y0[0] + y0[1]); }
#undef PAIR
                    if (kq == 0) *(LAS f32x2*)(yb + t * 64 + half * 32 + rb * 2) = (f32x2){y[0], y[1]};
                }
            } else {
                if (half == 0 && lane < 16) {
                    const LAS float* bo = BONc + (c & 1) * 32;
                    const size_t m = (size_t)b * PB + scan_row(dir, c * 16 + lane);
                    A.CB[(size_t)dir * MR * 16 + m * 16 + h] = bo[lane] + bo[16 + lane];
                }
                if (c >= 1) {
                    const int t = half * 8 + (lane >> 3), c8 = (lane & 7) * 8;
                    const LAS float* yb = YBc + ((c - 1) & 1) * 1024 + t * 64 + c8;
                    float f[8];
#pragma unroll
                    for (int i = 0; i < 8; ++i) f[i] = yb[i];
                    const size_t m = (size_t)b * PB + scan_row(dir, (c - 1) * 16 + t);
                    *(u32x4*)(Yd + m * DM + h * 64 + c8) = pack8(f);
                }
                if (c + 1 < NCH) { scan_process(RW_, half, INc + ((c + 1) & 1) * 6144, BONc + ((c + 1) & 1) * 32, lane, w2b, a2b, w0v, a0v, kkv, kav, rkv);
                                   if (c + 2 < NCH) scan_issue(A, dir, b, h, half, c + 2, lane, RW_); }
            }
            __syncthreads();
        }
        if (!consumer) {
            const int c = NCH;
            const int t = half * 8 + (lane >> 3), c8 = (lane & 7) * 8;
            const LAS float* yb = YBc + ((c - 1) & 1) * 1024 + t * 64 + c8;
            float f[8];
#pragma unroll
            for (int i = 0; i < 8; ++i) f[i] = yb[i];
            const size_t m = (size_t)b * PB + scan_row(dir, (c - 1) * 16 + t);
            *(u32x4*)(Yd + m * DM + h * 64 + c8) = pack8(f);
        }
        __syncthreads();
    }
}

enum { ST_NOP = 0, ST_P0, ST_NORM, ST_GEMM, ST_ATTN, ST_MIX, ST_SCAN, ST_POST, ST_CONV, ST_FINAL };
struct Step {
    int type, sync;
    pg8::Gemm g; EpiGen e;
    int i0, i1, i2;
    bf16_t* Vb;
};
constexpr int NSTEPS = 1 + 2 * 8 + 2 * 20 + 1;

__host__ __device__ __forceinline__ void make_step(int st, const Params& P, unsigned char* ws, Step& S) {
    const float* MOD = (const float*)(ws + WS_MOD);
    bf16_t* A0 = (bf16_t*)(ws + WS_A0); bf16_t* A1 = (bf16_t*)(ws + WS_A1); bf16_t* A2 = (bf16_t*)(ws + WS_A2); bf16_t* A3 = (bf16_t*)(ws + WS_A3); bf16_t* A4 = (bf16_t*)(ws + WS_A4);
    bf16_t* VF = (bf16_t*)(ws + WS_VF);
    bf16_t* WLb = (bf16_t*)(ws + WS_LORA); bf16_t* ALb = (bf16_t*)(ws + WS_LORA + LORA_SZ); bf16_t* GLb = (bf16_t*)(ws + WS_LORA + 2 * LORA_SZ); bf16_t* VLb = (bf16_t*)(ws + WS_LORA + 3 * LORA_SZ);
    const unsigned char* WB = ws + WS_W;
    S.type = ST_NOP; S.sync = 0; S.i0 = S.i1 = S.i2 = 0; S.Vb = nullptr;
    S.g = pg8::Gemm{nullptr, nullptr, MR, DM, DM, DM, DM, 0, 0};
    S.e = EpiGen{EM_BF16, nullptr, nullptr, nullptr, nullptr, nullptr, nullptr, P.out, (float*)(ws + WS_CTXR), DM, DM, 0, 0, 0, 0u};
    if (st == 0) { S.type = ST_P0; S.sync = 1; return; }
    if (st == NSTEPS - 1) { S.type = ST_FINAL; return; }
    int r = st - 1, layer = 0;
    for (;; ++layer) { const int len = (layer & 1) ? 20 : 8; if (r < len) break; r -= len; }
    const int j = layer >> 1; const bool rw = layer & 1; const int lastl = (layer == NLAYER - 1) ? 1 : 0;
    const float* mod = MOD + (size_t)layer * 17 * 6144;
    const int nmix = rw ? 16 : 4;
    if (r == 0) { S.type = ST_NORM; S.sync = 1; S.i0 = layer; S.i1 = 0; S.i2 = (layer == 0); return; }
    if (r >= nmix) {
        const int f = r - nmix;
        if (f == 0) { S.type = ST_NORM; S.sync = 1; S.i0 = layer; S.i1 = 1; S.i2 = 0; return; }
        bf16_t* HALO = A4; bf16_t* HB = (bf16_t*)(ws + WS_A4 + 16 * MiB);
        if (f == 1) { S.type = ST_GEMM; S.sync = 1; S.g = pg8::Gemm{HB, (const bf16_t*)(WB + W_UP2(layer)), 768, 2 * DFF, DM, DM, DM, 0, 0}; S.e.mode = EM_BF16; S.e.O = HALO; S.e.ldc = 2 * DFF; S.e.nstore = 2 * DFF; S.e.act = 0; }
        else if (f == 2) { S.type = ST_GEMM; S.sync = 1; S.g = pg8::Gemm{A0, (const bf16_t*)(WB + W_UP2(layer)), lastl ? NB * TL : MR, 2 * DFF, DM, DM, DM, 0, lastl}; S.e.mode = EM_GLU; S.e.O = A1; S.e.VFp = HALO;
                      S.e.f0 = P.in[9] + (size_t)layer * 3 * DFF; S.e.f1 = P.in[10] + (size_t)layer * DFF; }
        else { S.type = ST_GEMM; S.sync = 1; S.g = pg8::Gemm{A1, (const bf16_t*)(WB + W_DN2(layer)), lastl ? NB * TL : MR, DM, DFF, DFF, DFF, 0, lastl}; S.e.mode = EM_RES; S.e.f0 = mod; S.e.k = 5; S.e.row_off = 0; }
        return;
    }
    if (!rw) {
        if (r == 1) { S.type = ST_GEMM; S.sync = 1; S.g = pg8::Gemm{A0, (const bf16_t*)(WB + W_QKV(j)), MR, 3072, DM, DM, DM, 0, 0}; S.e.mode = EM_QKV; S.e.O = A1; S.e.O2 = A2; S.e.O3 = A3; S.e.f0 = (const float*)(ws + WS_ROPE); }
        else if (r == 2) { S.type = ST_ATTN; S.sync = 1; S.i0 = j; S.i1 = layer; }
        else { S.type = ST_GEMM; S.sync = 1; S.g = pg8::Gemm{A0, (const bf16_t*)(WB + W_AO(j)), MR, DM, DM, DM, DM, 0, 0}; S.e.mode = EM_RES; S.e.f0 = mod; S.e.k = 2; S.e.row_off = 0; }
        return;
    }
    const unsigned char* RW = WB + W_RWB(j);
    bf16_t* Vb = (j == 0) ? VF : A3; S.Vb = Vb;
    switch (r) {
    case 1: S.type = ST_MIX; S.sync = 1; S.i0 = 2; S.i1 = 3; S.i2 = j; break;
    case 2: S.type = ST_GEMM; S.g = pg8::Gemm{A1, (const bf16_t*)(RW + RW_K), MR, DM, DM, DM, DM, 0, 0}; S.e.O = A4; break;
    case 3: S.type = ST_GEMM; S.g = pg8::Gemm{A2, (const bf16_t*)(RW + RW_V), MR, DM, DM, DM, DM, 192, 0}; S.e.O = Vb; break;
    case 4: S.sync = 1; if (j > 0) { S.type = ST_GEMM; S.g = pg8::Gemm{A2, (const bf16_t*)(RW + RW_V1), MR, 256, DM, DM, DM, 128, 0}; S.e.O = VLb; S.e.ldc = 128; S.e.nstore = 128; } break;
    case 5: S.type = ST_MIX; S.sync = 1; S.i0 = 1; S.i1 = 4; S.i2 = j | 256; break;
    case 6: S.type = ST_GEMM; S.g = pg8::Gemm{A1, (const bf16_t*)(RW + RW_W1), MR, 256, DM, DM, DM, 0, 0}; S.e.O = WLb; S.e.ldc = 128; S.e.nstore = 128; S.e.act = 1; break;
    case 7: S.type = ST_GEMM; S.g = pg8::Gemm{A2, (const bf16_t*)(RW + RW_A1), MR, 256, DM, DM, DM, 240, 0}; S.e.O = ALb; S.e.ldc = 128; S.e.nstore = 128; break;
    case 8: S.sync = 1; if (j > 0) { S.type = ST_GEMM; S.g = pg8::Gemm{VLb, (const bf16_t*)(RW + RW_V2), MR, DM, 128, 128, 128, 224, 0}; S.e.mode = EM_VMIX; S.e.O = Vb; S.e.VFp = VF; S.e.f0 = P.in[27] + (size_t)(j - 1) * DM; } break;
    case 9: S.type = ST_MIX; S.sync = 1; S.i0 = 5; S.i1 = 0; S.i2 = j; break;
    case 10: S.type = ST_GEMM; S.g = pg8::Gemm{A1, (const bf16_t*)(RW + RW_G1), MR, 256, DM, DM, DM, 0, 0}; S.e.O = GLb; S.e.ldc = 128; S.e.nstore = 128; S.e.act = 2; break;
    case 11: S.type = ST_GEMM; S.sync = 1; S.g = pg8::Gemm{A2, (const bf16_t*)(RW + RW_R), MR, DM, DM, DM, DM, 240, 0}; S.e.O = A0; break;
    case 12: S.type = ST_SCAN; S.sync = 1; S.i0 = j; break;
    case 13: S.type = ST_POST; S.sync = 1; S.i0 = j; break;
    case 14: S.type = ST_GEMM; S.sync = 1; S.g = pg8::Gemm{GLb, (const bf16_t*)(RW + RW_G2), lastl ? NB * TL : MR, DM, 128, 128, 128, 0, lastl}; S.e.mode = EM_MULZ; S.e.O = A4; break;
    default: S.type = ST_GEMM; S.sync = 1; S.g = pg8::Gemm{A4, (const bf16_t*)(RW + RW_O), lastl ? NB * TL : MR, DM, DM, DM, DM, 0, lastl}; S.e.mode = EM_RES; S.e.f0 = mod; S.e.k = 2; S.e.row_off = 0; break;
    }
}

template <int TYPE> __device__ __forceinline__ void run_step(const Params& P, unsigned char* ws, const Step& S, LAS unsigned char* lds, unsigned char* lds_raw) {
    float* XL = P.out; float* XC = (float*)(ws + WS_CTXR);
    bf16_t* A0 = (bf16_t*)(ws + WS_A0); bf16_t* A1 = (bf16_t*)(ws + WS_A1); bf16_t* A2 = (bf16_t*)(ws + WS_A2); bf16_t* A3 = (bf16_t*)(ws + WS_A3); bf16_t* A4 = (bf16_t*)(ws + WS_A4);
    const float* MOD = (const float*)(ws + WS_MOD);
    float* KN = (float*)(ws + WS_KNORM); float* CB = (float*)(ws + WS_CB2);
    if constexpr (TYPE == ST_P0) { phase_p0(P, ws, lds); }
    else if constexpr (TYPE == ST_NORM) {
        const int layer = S.i0; const float* mod = MOD + (size_t)layer * 17 * 6144;
        const float* g = (S.i1 ? P.in[7] : P.in[6]) + layer * DM;
        bf16_t* HB = S.i1 ? (bf16_t*)(ws + WS_A4 + 16 * MiB) : nullptr;
        if (S.i2) phase_norm_mod(P.in[0], P.in[2], XL, XC, g, mod, S.i1, A0, HB);
        else phase_norm_mod(XL, XC, nullptr, nullptr, g, mod, S.i1, A0, HB);
    }
    else if constexpr (TYPE == ST_GEMM) { EpiGen e = S.e; e.ldsb = (unsigned)(uintptr_t)lds + 131072u; pg8::gemm_phase(lds, S.g, e); }
    else if constexpr (TYPE == ST_ATTN) {
        const int j = S.i0; const float lambda_init = (S.i1 == 0) ? 0.2f : 0.47071301835f;
        phase_attn(A1, A2, A3, A0, (float*)A4, P.in[13] + j * 256, lambda_init, P.in[14] + j * 128, (char*)lds_raw);
    }
    else if constexpr (TYPE == ST_MIX) {
        const int j = S.i2 & 255; const bool kn = (S.i2 & 256) != 0;
        const float* mp = P.in[16] + (size_t)j * 6 * DM; const float* mn = P.in[17] + (size_t)j * 6 * DM;
        phase_mix(A0, mp, mn, S.i0, S.i1, A1, A2, kn ? A4 : nullptr, P.in[30] + j * DM, kn ? KN : nullptr);
    }
    else if constexpr (TYPE == ST_SCAN) {
        const int j = S.i0; const unsigned char* RW = ws + WS_W + W_RWB(j);
        ScanArgs SA{A0, A4, S.Vb, (bf16_t*)(ws + WS_LORA), (bf16_t*)(ws + WS_LORA + LORA_SZ), KN, (const bf16_t*)(RW + RW_W2), (const bf16_t*)(RW + RW_A2), P.in[21] + (size_t)j * 2 * DM, P.in[24] + (size_t)j * 2 * DM,
                    P.in[30] + j * DM, P.in[31] + j * DM, P.in[32] + j * DM, A1, A2, CB};
        phase_scan(SA, lds);
    }
    else if constexpr (TYPE == ST_POST) { const int j = S.i0; phase_post(A1, A2, S.Vb, CB, P.in[35] + j * DM, P.in[36] + j * DM, A4); }
    else if constexpr (TYPE == ST_CONV) { const int layer = S.i0; phase_convact(A1, A4, S.i1, S.i2, P.in[9] + (size_t)layer * 3 * DFF, P.in[10] + (size_t)layer * DFF); }
    else if constexpr (TYPE == ST_FINAL) { phase_final_norm(XL, P.in[38]); }
}

#ifndef FUSED
#define FUSED 1
#endif
#if FUSED
__global__ void __launch_bounds__(NTHR, 2) fwd_megakernel(Params P) {
    extern __shared__ __attribute__((aligned(16))) unsigned char lds_raw[];
    LAS unsigned char* lds = (LAS unsigned char*)lds_raw;
    cg::grid_group grid = cg::this_grid();
    volatile LAS unsigned* bst = (volatile LAS unsigned*)(lds + 147456);
    if (threadIdx.x < 2) bst[threadIdx.x] = 0u;
    __syncthreads();
    (void)xcd_barrier_post((unsigned*)(P.ws + WS_BAR), bst);
    for (int st = 0; st < NSTEPS; ++st) {
        unsigned char* ws;
        { unsigned lo = P.ws_lo, hi = P.ws_hi;
          asm volatile("" : "+s"(lo), "+s"(hi));
          typedef __attribute__((address_space(1))) unsigned char gbyte_t;
          ws = (unsigned char*)(gbyte_t*)(((uintptr_t)hi << 32) | (uintptr_t)lo); }
        Step S; make_step(st, P, ws, S);
        switch (S.type) {
        case ST_P0: run_step<ST_P0>(P, ws, S, lds, lds_raw); break;
        case ST_NORM: run_step<ST_NORM>(P, ws, S, lds, lds_raw); break;
        case ST_GEMM: run_step<ST_GEMM>(P, ws, S, lds, lds_raw); break;
        case ST_ATTN: run_step<ST_ATTN>(P, ws, S, lds, lds_raw); break;
        case ST_MIX: run_step<ST_MIX>(P, ws, S, lds, lds_raw); break;
        case ST_SCAN: run_step<ST_SCAN>(P, ws, S, lds, lds_raw); break;
        case ST_POST: run_step<ST_POST>(P, ws, S, lds, lds_raw); break;
        case ST_CONV: run_step<ST_CONV>(P, ws, S, lds, lds_raw); break;
        case ST_FINAL: run_step<ST_FINAL>(P, ws, S, lds, lds_raw); break;
        default: break;
        }
#if defined(PROBE_DUP)
        if (S.type == PROBE_DUP) {
            grid.sync();
            switch (S.type) {
            case ST_ATTN: run_step<ST_ATTN>(P, ws, S, lds, lds_raw); break;
            case ST_SCAN: run_step<ST_SCAN>(P, ws, S, lds, lds_raw); break;
            case ST_CONV: run_step<ST_CONV>(P, ws, S, lds, lds_raw); break;
            case ST_MIX: run_step<ST_MIX>(P, ws, S, lds, lds_raw); break;
            case ST_NORM: run_step<ST_NORM>(P, ws, S, lds, lds_raw); break;
            case ST_POST: run_step<ST_POST>(P, ws, S, lds, lds_raw); break;
            case ST_P0: run_step<ST_P0>(P, ws, S, lds, lds_raw); break;
            default: break;
            }
        }
#endif
        if (S.sync) { if (st == 0) grid.sync(); else { XcdBarrier xb; xb.bar = (unsigned*)(ws + WS_BAR); xb.x = xb_xcc_id(); xb.st = (volatile LAS unsigned*)(lds + 147456); xcd_barrier(xb); } }
#if defined(PROBE_SYNC)
        if (S.sync) { grid.sync(); grid.sync(); }
#endif
    }
}
#else
template <int TYPE> __global__ void __launch_bounds__(NTHR, 2) k_step(Params P, int st) {
    extern __shared__ __attribute__((aligned(16))) unsigned char lds_raw[];
    LAS unsigned char* lds = (LAS unsigned char*)lds_raw;
    Step S; make_step(st, P, P.ws, S);
    run_step<TYPE>(P, P.ws, S, lds, lds_raw);
}
template <int TYPE> static void launch_step(const Params& P, int st, int grid, hipStream_t stream) {
    static bool attr_done = false;
    if (!attr_done) { (void)hipFuncSetAttribute((const void*)k_step<TYPE>, hipFuncAttributeMaxDynamicSharedMemorySize, LDS_BYTES); attr_done = true; }
    hipLaunchKernelGGL(k_step<TYPE>, dim3(grid), dim3(NTHR), LDS_BYTES, stream, P, st);
}
#endif

extern "C" void kernel_launch(void* const* d_in, const int* in_sizes, int n_in, void* d_out, int out_size, void* d_ws, size_t ws_size, hipStream_t stream) {
    static int grid = 0;
    if (grid == 0) {
        if (n_in != 39 || out_size != NB * TL * DM || ws_size < WS_END) { fprintf(stderr, "kernel_launch: unexpected shapes n_in %d out %d ws %zu (need %zu)\n", n_in, out_size, ws_size, (size_t)WS_END); grid = -1; return; }
        int dev = 0, cus = 0, per_cu = 1;
        (void)hipGetDevice(&dev); (void)hipDeviceGetAttribute(&cus, hipDeviceAttributeMultiprocessorCount, dev);
#if FUSED
        if (hipFuncSetAttribute((const void*)fwd_megakernel, hipFuncAttributeMaxDynamicSharedMemorySize, LDS_BYTES) != hipSuccess) { fprintf(stderr, "kernel_launch: hipFuncSetAttribute failed\n"); grid = -1; return; }
        if (hipOccupancyMaxActiveBlocksPerMultiprocessor(&per_cu, (const void*)fwd_megakernel, NTHR, LDS_BYTES) != hipSuccess || per_cu < 1) { fprintf(stderr, "kernel_launch: occupancy query gave %d\n", per_cu); per_cu = 1; }
        (void)hipGetLastError();
#endif
        grid = cus * per_cu;
        fprintf(stderr, "kernel_launch: grid %d (cus %d x %d), ws %zu\n", grid, cus, per_cu, ws_size);
    }
    if (grid < 0) return;
    Params P; memset(&P, 0, sizeof(P));
    for (int i = 0; i < 39; ++i) P.in[i] = (const float*)d_in[i];
    P.out = (float*)d_out; P.ws = (unsigned char*)d_ws; P.ws_lo = (unsigned)((uintptr_t)d_ws & 0xffffffffu); P.ws_hi = (unsigned)((uintptr_t)d_ws >> 32);
    unsigned char* WBh = (unsigned char*)d_ws + WS_W;
    int nj = 0;
    auto add = [&](const float* src, size_t dst_off, int Ksrc, int Kdst, int Nsrc, int Ndst, int dld, int perm) {
        TJob& J = P.jobs[nj++]; J.src = src; J.dst = (bf16_t*)(WBh + dst_off); J.Ksrc = Ksrc; J.Kdst = Kdst; J.Nsrc = Nsrc; J.Ndst = Ndst; J.dld = dld; J.perm = perm; };
    for (int j = 0; j < 2; ++j) {
        add(P.in[12] + (size_t)j * DM * 3072, W_QKV(j), DM, DM, 3072, 3072, DM, 1);
        add(P.in[15] + (size_t)j * DM * DM, W_AO(j), DM, DM, DM, DM, DM, 0);
    }
    for (int i = 0; i < 4; ++i) {
        add(P.in[8] + (size_t)i * DM * 2 * DFF, W_UP2(i), DM, DM, 2 * DFF, 2 * DFF, DM, 2);
        add(P.in[11] + (size_t)i * DFF * DM, W_DN2(i), DFF, DFF, DM, DM, DFF, 0);
    }
    for (int j = 0; j < 2; ++j) {
        const size_t rb = W_RWB(j);
        add(P.in[18] + (size_t)j * DM * DM, rb + RW_R, DM, DM, DM, DM, DM, 0);
        add(P.in[19] + (size_t)j * DM * DM, rb + RW_K, DM, DM, DM, DM, DM, 0);
        add(P.in[20] + (size_t)j * DM * DM, rb + RW_V, DM, DM, DM, DM, DM, 0);
        add(P.in[37] + (size_t)j * DM * DM, rb + RW_O, DM, DM, DM, DM, DM, 0);
        add(P.in[22] + ((size_t)j * 2 + 0) * DM * 64, rb + RW_W1, DM, DM, 64, 64, DM, 0);
        add(P.in[22] + ((size_t)j * 2 + 1) * DM * 64, rb + RW_W1 + (size_t)64 * DM * 2, DM, DM, 64, 192, DM, 0);
        add(P.in[25] + ((size_t)j * 2 + 0) * DM * 64, rb + RW_A1, DM, DM, 64, 64, DM, 0);
        add(P.in[25] + ((size_t)j * 2 + 1) * DM * 64, rb + RW_A1 + (size_t)64 * DM * 2, DM, DM, 64, 192, DM, 0);
        add(P.in[33] + (size_t)j * DM * 128, rb + RW_G1, DM, DM, 128, 256, DM, 0);
        if (j > 0) add(P.in[28] + (size_t)(j - 1) * DM * 32, rb + RW_V1, DM, DM, 32, 256, DM, 0);
        add(P.in[34] + (size_t)j * 128 * DM, rb + RW_G2, 128, 128, DM, DM, 128, 0);
        if (j > 0) add(P.in[29] + (size_t)(j - 1) * 32 * DM, rb + RW_V2, 32, 128, DM, DM, 128, 0);
        for (int d = 0; d < 2; ++d) {
            add(P.in[23] + ((size_t)j * 2 + d) * 64 * DM, rb + RW_W2 + (size_t)d * DM * 64 * 2, 64, 64, DM, DM, 64, 0);
            add(P.in[26] + ((size_t)j * 2 + d) * 64 * DM, rb + RW_A2 + (size_t)d * DM * 64 * 2, 64, 64, DM, DM, 64, 0);
        }
    }
    P.njobs = nj;
#if FUSED
    (void)hipMemsetAsync((char*)d_ws + WS_BAR, 0, 16384, stream);
    void* args[] = {&P};
    hipError_t e = hipLaunchCooperativeKernel((const void*)fwd_megakernel, dim3(grid), dim3(NTHR), args, LDS_BYTES, stream);
    if (e != hipSuccess) fprintf(stderr, "cooperative launch failed: %s (grid %d)\n", hipGetErrorString(e), grid);
#else
    for (int st = 0; st < NSTEPS; ++st) {
        Step S; make_step(st, P, P.ws, S);
        switch (S.type) {
        case ST_P0: launch_step<ST_P0>(P, st, grid, stream); break;
        case ST_NORM: launch_step<ST_NORM>(P, st, grid, stream); break;
        case ST_GEMM: launch_step<ST_GEMM>(P, st, grid, stream); break;
        case ST_ATTN: launch_step<ST_ATTN>(P, st, grid, stream); break;
        case ST_MIX: launch_step<ST_MIX>(P, st, grid, stream); break;
        case ST_SCAN: launch_step<ST_SCAN>(P, st, grid, stream); break;
        case ST_POST: launch_step<ST_POST>(P, st, grid, stream); break;
        case ST_CONV: launch_step<ST_CONV>(P, st, grid, stream); break;
        case ST_FINAL: launch_step<ST_FINAL>(P, st, grid, stream); break;
        default: break;
        }
    }
#endif
}
```

```cpp
#include <hip/hip_runtime.h>
#include <hip/hip_cooperative_groups.h>
#include <cstdio>
#include <cstdint>
#include <cstring>
namespace cg = cooperative_groups;

#define LAS __attribute__((address_space(3)))
typedef unsigned short bf16_t;
typedef short bf16x8 __attribute__((ext_vector_type(8)));
typedef short s16x4 __attribute__((ext_vector_type(4)));
typedef float f32x4 __attribute__((ext_vector_type(4)));
typedef float f32x2 __attribute__((ext_vector_type(2)));
typedef float f32x16 __attribute__((ext_vector_type(16)));
typedef unsigned u32x4 __attribute__((ext_vector_type(4)));
typedef unsigned u32x2 __attribute__((ext_vector_type(2)));

constexpr int DM = 1024, NB = 16, TL = 4096, TC = 256, PB = TL + TC  , MR = NB * PB  ;
constexpr int DFF = 2816, NLAYER = 4;
constexpr int NWAVES = 8, NTHR = 512;
constexpr int LDS_BYTES = 155648;
constexpr size_t MiB = 1u << 20;
constexpr size_t WS_ROPE = 0;
constexpr size_t WS_BAR = 64 * 1024;
constexpr size_t WS_MOD = 1 * MiB;
constexpr size_t WS_KNORM = 3 * MiB;
constexpr size_t WS_W = 16 * MiB;
constexpr size_t WS_CTXR = 120 * MiB;
constexpr size_t WS_VF = 136 * MiB;
constexpr size_t WS_A0 = 272 * MiB, ABLK = 136 * MiB;
constexpr size_t WS_A1 = WS_A0 + ABLK, WS_A2 = WS_A1 + ABLK, WS_A3 = WS_A2 + ABLK, WS_A4 = WS_A3 + ABLK;
constexpr size_t WS_LORA = 952 * MiB;
constexpr size_t LORA_SZ = 17 * MiB;
constexpr size_t WS_END = 1020 * MiB;
constexpr size_t WS_CB2 = (size_t)(7.5 * 1048576.0);

__device__ __forceinline__ int tid_() { int t = threadIdx.x; asm volatile("" : "+v"(t)); return t; }
__device__ __forceinline__ int bid_() { int b = blockIdx.x; asm volatile("" : "+s"(b)); return b; }
__device__ __forceinline__ int gdim_() { int g = gridDim.x; asm volatile("" : "+s"(g)); return g; }
__device__ __forceinline__ unsigned cvt_pk_bf16(float lo, float hi) { unsigned r; asm volatile("v_cvt_pk_bf16_f32 %0, %1, %2" : "=v"(r) : "v"(lo), "v"(hi)); return r; }
__device__ __forceinline__ float bflo(unsigned w) { return __uint_as_float(w << 16); }
__device__ __forceinline__ float bfhi(unsigned w) { return __uint_as_float(w & 0xffff0000u); }
__device__ __forceinline__ float bf2f(bf16_t h) { return __uint_as_float((unsigned)h << 16); }
__device__ __forceinline__ float wave_sum(float v) {
#pragma unroll
    for (int o = 1; o < 64; o <<= 1) v += __shfl_xor(v, o);
    return v;
}
__device__ __forceinline__ float dpp_f(float x, const int ctrl_dummy) { return x; }
#define DPP_ADD(x, ctrl) ((x) + __int_as_float(__builtin_amdgcn_update_dpp(0, __float_as_int(x), (ctrl), 0xF, 0xF, true)))
__device__ __forceinline__ float red4(float x) { x = DPP_ADD(x, 0xB1); x = DPP_ADD(x, 0x4E); return x; }
__device__ __forceinline__ float red8(float x) { x = red4(x); x = DPP_ADD(x, 0x141); return x; }
__device__ __forceinline__ float red16(float x) { x = red8(x); x = DPP_ADD(x, 0x140); return x; }
__device__ __forceinline__ float sigmoidf_(float x) { return __builtin_amdgcn_rcpf(1.f + __expf(-x)); }
__device__ __forceinline__ void unpack8(u32x4 w, float* f) { f[0] = bflo(w.x); f[1] = bfhi(w.x); f[2] = bflo(w.y); f[3] = bfhi(w.y); f[4] = bflo(w.z); f[5] = bfhi(w.z); f[6] = bflo(w.w); f[7] = bfhi(w.w); }
__device__ __forceinline__ u32x4 pack8(const float* f) { u32x4 w; w.x = cvt_pk_bf16(f[0], f[1]); w.y = cvt_pk_bf16(f[2], f[3]); w.z = cvt_pk_bf16(f[4], f[5]); w.w = cvt_pk_bf16(f[6], f[7]); return w; }


#define XB_TMO      128
#define XB_XCNT(j)  (256  + 64 * (j))
#define XB_XSUB(j)  (1280 + 64 * (j))
#define XB_XGEN(j)  (2304 + 64 * (j))
#define XB_TOP      3328
#define XB_TOPGEN   3392
#define XCD_BAR_WORDS 3456
#define XB_SPIN_CAP (1u << 22)
__device__ __forceinline__ unsigned xb_ld(unsigned* p)              { return __hip_atomic_load(p, __ATOMIC_RELAXED, __HIP_MEMORY_SCOPE_AGENT); }
__device__ __forceinline__ unsigned xb_add(unsigned* p, unsigned v) { return __hip_atomic_fetch_add(p, v, __ATOMIC_RELAXED, __HIP_MEMORY_SCOPE_AGENT); }
__device__ __forceinline__ unsigned xb_xcc_id() { return (unsigned)__builtin_amdgcn_s_getreg((3 << 11) | 20) & 0xFu; }
#define XB_SPIN(cond, bar) do { unsigned _sp = 0; while (cond) { __builtin_amdgcn_s_sleep(1); \
    if ((++_sp & 255u) == 0u) { if (xb_ld(&(bar)[XB_TMO])) break; if (_sp > XB_SPIN_CAP) { atomicAdd(&(bar)[XB_TMO], 1u); break; } } } } while (0)
struct XcdBarrier { unsigned* bar; unsigned x; volatile LAS unsigned* st; };
__device__ __forceinline__ XcdBarrier xcd_barrier_post(unsigned* bar, volatile LAS unsigned* st) {
    XcdBarrier b; b.bar = bar; b.x = xb_xcc_id(); b.st = st;
    if (threadIdx.x == 0) (void)xb_add(&bar[XB_XCNT(b.x)], 1u);
    return b;
}
__device__ __forceinline__ void xcd_barrier_complete(unsigned* bar, unsigned x, unsigned& nloc, unsigned& nx) {
    const unsigned G = gridDim.x * gridDim.y * gridDim.z;
    unsigned sum, cnt, mine, sp = 0u;
    for (;;) {
        sum = 0u; cnt = 0u; mine = 0u;
#pragma unroll
        for (unsigned j = 0; j < 16; ++j) { const unsigned c = xb_ld(&bar[XB_XCNT(j)]); sum += c; cnt += (c > 0u) ? 1u : 0u; mine = (j == x) ? c : mine; }
        if (sum == G) break;
        __builtin_amdgcn_s_sleep(1);
        if ((++sp & 255u) == 0u) { if (xb_ld(&bar[XB_TMO])) break; if (sp > XB_SPIN_CAP) { atomicAdd(&bar[XB_TMO], 1u); break; } }
    }
    nloc = mine > 0u ? mine : 1u; nx = cnt > 0u ? cnt : 1u;
}
__device__ __forceinline__ void xcd_barrier(const XcdBarrier& b) {
    asm volatile("s_waitcnt vmcnt(0)" ::: "memory");
    __syncthreads();
    if (threadIdx.x == 0) {
        unsigned* bar = b.bar;
        __builtin_amdgcn_s_waitcnt(0);
        unsigned nloc = b.st[0], nx = b.st[1];
        if (nloc == 0u) { xcd_barrier_complete(bar, b.x, nloc, nx); b.st[0] = nloc; b.st[1] = nx; }
        const unsigned old = xb_add(&bar[XB_XSUB(b.x)], 1u);
        const unsigned gen = old / nloc;
        if (old + 1u == (gen + 1u) * nloc) {
            __builtin_amdgcn_fence(__ATOMIC_RELEASE, "agent");
            asm volatile("s_waitcnt vmcnt(0)" ::: "memory");
            const unsigned og = xb_add(&bar[XB_TOP], 1u);
            const unsigned tg = og / nx;
            if (og + 1u == (tg + 1u) * nx) xb_add(&bar[XB_TOPGEN], 1u);
            else XB_SPIN(xb_ld(&bar[XB_TOPGEN]) == tg, bar);
            __builtin_amdgcn_fence(__ATOMIC_ACQUIRE, "agent");
            xb_add(&bar[XB_XGEN(b.x)], 1u);
            asm volatile("s_waitcnt vmcnt(0)" ::: "memory");
        } else {
            XB_SPIN(xb_ld(&bar[XB_XGEN(b.x)]) == gen, bar);
            __builtin_amdgcn_fence(__ATOMIC_ACQUIRE, "agent");
            asm volatile("s_waitcnt vmcnt(0)" ::: "memory");
        }
    }
    __syncthreads();
}

namespace pg8 {
constexpr int BM = 256, BK = 64, HALF = 128, HTB = HALF * BK * 2, STAGE_BYTES = 8 * HTB, NXCD = 8, WGM = 4;
__host__ __device__ __forceinline__ int lds_byte(int r, int c) { const int st = (r >> 4) * 2 + (c >> 5), rr = r & 15, cc = c & 31, ob = rr * 64 + cc * 2; return st * 1024 + (ob ^ (((ob >> 9) & 1) << 5)); }
__host__ __device__ __forceinline__ void stage_rc(int b, int& R, int& C) { const int st = b / 1024, sb = b % 1024, swz = sb ^ (((sb >> 9) & 1) << 5); R = (st >> 1) * 16 + swz / 64; C = (st & 1) * 32 + (swz % 64) / 2; }
__host__ __device__ __forceinline__ int perm32(int rho) { const int n = rho >> 4, i = rho & 15; return 8 * (i >> 2) + 4 * n + (i & 3); }
struct Unit { int pm, pn; };
struct Gemm { const bf16_t* A; const bf16_t* Bt; int M, N, K, lda, ldb; int rot, lat_only; };
struct StaticOrder {
    int nM, nN, nwg, G, c, lat;
    __device__ void init(int M, int N, int G_, int c_, int lat_) { nM = M / BM; nN = N / BM; nwg = nM * nN; G = G_; c = c_; lat = lat_; }
    __device__ bool next(int i, Unit& u) const {
        const long L = (long)i * G + c; if (L >= nwg) return false;
        int wgid = (int)L; { const int q = nwg / NXCD, r = nwg % NXCD, xcd = wgid % NXCD, off = wgid / NXCD; wgid = (xcd < r ? xcd * (q + 1) : r * (q + 1) + (xcd - r) * q) + off; }
        const int nig = WGM * nN, gid = wgid / nig, fm = gid * WGM, gsz = (nM - fm) < WGM ? (nM - fm) : WGM;
        u.pm = fm + ((wgid % nig) % gsz); u.pn = (wgid % nig) / gsz;
        if (lat) u.pm = (u.pm >> 4) * 17 + 1 + (u.pm & 15);
        return true;
    }
};
template <class Epi>
__device__ __forceinline__ void gemm_phase(LAS unsigned char* lds, const Gemm g, const Epi& E) {
    StaticOrder S; { const int G_ = gdim_(); int c_ = bid_() + g.rot; if (c_ >= G_) c_ -= G_; S.init(g.M, g.N, G_, c_, g.lat_only); }
    const int tid = tid_(), wid = __builtin_amdgcn_readfirstlane(tid >> 6), lane = tid & 63, wr = wid >> 2, wc = wid & 3, fr = lane & 15, fq = lane >> 4;
    const int K = g.K, nt = K / BK;
    unsigned voffA[2], voffB[2];
#pragma unroll
    for (int i = 0; i < 2; ++i) { int R, C; stage_rc(tid * 16 + i * 8192, R, C); const int Rb = (R & ~31) + perm32(R & 31);
        voffA[i] = (unsigned)(R * g.lda + C) * 2u; voffB[i] = (unsigned)(Rb * g.ldb + C) * 2u; }
    const size_t kstep = (size_t)(BK * 2);
    const size_t hstepA = (size_t)HALF * g.lda * 2, hstepB = (size_t)HALF * g.ldb * 2;
    const size_t tstepA = 2 * hstepA, tstepB = 2 * hstepB;
    const unsigned ldsw = (unsigned)wid * 1024u;
    const int aoff = lds_byte(wr * 64 + fr, fq * 8), boff = lds_byte(wc * 32 + fr, fq * 8);
#define PG8_SA(b, h) (((b) * 2 + (h)) * HTB)
#define PG8_SB(b, h) ((4 + (b) * 2 + (h)) * HTB)
#define PG8_STAGE(bufoff, gbase, voff) do { _Pragma("unroll") for (int _i = 0; _i < 2; ++_i) \
        __builtin_amdgcn_global_load_lds((const unsigned*)((const char*)(gbase) + (voff)[_i]), (LAS unsigned*)(lds + (bufoff) + ldsw + _i * 8192), 16, 0, 0); } while (0)
#define PG8_LDA(dst, b, h) do { _Pragma("unroll") for (int m = 0; m < 4; ++m) _Pragma("unroll") for (int k = 0; k < 2; ++k) dst[m][k] = *(const LAS bf16x8*)(lds + PG8_SA(b, h) + aoff + m * 2048 + k * 1024); } while (0)
#define PG8_LDB(dst, b, h) do { _Pragma("unroll") for (int n = 0; n < 2; ++n) _Pragma("unroll") for (int k = 0; k < 2; ++k) dst[n][k] = *(const LAS bf16x8*)(lds + PG8_SB(b, h) + boff + n * 2048 + k * 1024); } while (0)
#define PG8_MMA(ai, bj, At, Bt) do { __builtin_amdgcn_s_setprio(1); _Pragma("unroll") for (int m = 0; m < 4; ++m) _Pragma("unroll") for (int n = 0; n < 2; ++n) _Pragma("unroll") for (int k = 0; k < 2; ++k) \
        acc[ai][bj][m][n] = __builtin_amdgcn_mfma_f32_16x16x32_bf16(Bt[n][k], At[m][k], acc[ai][bj][m][n], 0, 0, 0); __builtin_amdgcn_s_setprio(0); } while (0)
#define PG8_WAIT_V(n) asm volatile("s_waitcnt vmcnt(" #n ")" ::: "memory")
#define PG8_WAIT_L(n) asm volatile("s_waitcnt lgkmcnt(" #n ")" ::: "memory")
#define PG8_BAR __builtin_amdgcn_s_barrier()
#define PG8_SCHED __builtin_amdgcn_sched_barrier(0)
    Unit cur, nxt; int ui = 0;
    if (!S.next(0, cur)) return;
    f32x4 acc[2][2][4][2];
#pragma unroll
    for (int a = 0; a < 2; ++a)
#pragma unroll
        for (int b = 0; b < 2; ++b)
#pragma unroll
            for (int m = 0; m < 4; ++m)
#pragma unroll
                for (int n = 0; n < 2; ++n) acc[a][b][m][n] = (f32x4){0.f, 0.f, 0.f, 0.f};
    bf16x8 At[4][2], B0[2][2], B1[2][2];
    const char* cA = (const char*)g.A + (size_t)cur.pm * tstepA; const char* cB = (const char*)g.Bt + (size_t)cur.pn * tstepB;
    PG8_STAGE(PG8_SB(0, 0), cB, voffB); PG8_STAGE(PG8_SB(0, 1), cB + hstepB, voffB); PG8_STAGE(PG8_SA(0, 0), cA, voffA); PG8_STAGE(PG8_SA(0, 1), cA + hstepA, voffA);
    if (wr == 1) PG8_BAR;
    PG8_WAIT_V(2); PG8_BAR;
    PG8_STAGE(PG8_SB(1, 0), cB + kstep, voffB); PG8_STAGE(PG8_SA(1, 0), cA + kstep, voffA); PG8_STAGE(PG8_SB(1, 1), cB + hstepB + kstep, voffB);
    PG8_WAIT_V(6); PG8_BAR;
    for (;;) {
        const bool has_next = S.next(ui + 1, nxt);
        const char* nA = has_next ? (const char*)g.A + (size_t)nxt.pm * tstepA : cA; const char* nB = has_next ? (const char*)g.Bt + (size_t)nxt.pn * tstepB : cB;
        for (int t = 0; t < nt; t += 2) {
            const bool last = (t == nt - 2);
            const char* a1 = cA + (size_t)(t + 1) * kstep;
            const char* a2 = last ? nA : cA + (size_t)(t + 2) * kstep; const char* b2 = last ? nB : cB + (size_t)(t + 2) * kstep;
            const char* a3 = a2 + kstep; const char* b3 = b2 + kstep;
            PG8_LDB(B0, 0, 0); PG8_LDB(B1, 0, 1); PG8_SCHED; PG8_LDA(At, 0, 0); PG8_STAGE(PG8_SA(1, 1), a1 + hstepA, voffA);
            PG8_WAIT_V(8); PG8_WAIT_L(0); PG8_BAR; PG8_MMA(0, 0, At, B0); PG8_MMA(0, 1, At, B1); PG8_BAR; PG8_SCHED;
            PG8_LDA(At, 0, 1); PG8_STAGE(PG8_SB(0, 0), b2, voffB); PG8_STAGE(PG8_SB(0, 1), b2 + hstepB, voffB); PG8_STAGE(PG8_SA(0, 0), a2, voffA);
            PG8_WAIT_V(8); PG8_WAIT_L(0); PG8_BAR; PG8_MMA(1, 0, At, B0); PG8_MMA(1, 1, At, B1); PG8_BAR; PG8_SCHED;
            PG8_LDB(B0, 1, 0); PG8_LDB(B1, 1, 1); PG8_SCHED; PG8_LDA(At, 1, 0); PG8_STAGE(PG8_SA(0, 1), a2 + hstepA, voffA);
            PG8_WAIT_V(8); PG8_WAIT_L(0); PG8_BAR; PG8_MMA(0, 0, At, B0); PG8_MMA(0, 1, At, B1); PG8_BAR; PG8_SCHED;
            PG8_LDA(At, 1, 1); PG8_STAGE(PG8_SB(1, 0), b3, voffB); PG8_STAGE(PG8_SB(1, 1), b3 + hstepB, voffB); PG8_STAGE(PG8_SA(1, 0), a3, voffA);
            PG8_WAIT_V(8); PG8_WAIT_L(0); PG8_BAR; PG8_MMA(1, 0, At, B0); PG8_MMA(1, 1, At, B1); PG8_BAR; PG8_SCHED;
        }
        if (wr == 0) PG8_BAR;
        E(acc, cur, wr, wc, fr, fq);
        if (!has_next) break;
#pragma unroll
        for (int a = 0; a < 2; ++a)
#pragma unroll
            for (int b = 0; b < 2; ++b)
#pragma unroll
                for (int m = 0; m < 4; ++m)
#pragma unroll
                    for (int n = 0; n < 2; ++n) acc[a][b][m][n] = (f32x4){0.f, 0.f, 0.f, 0.f};
        cur = nxt; cA = nA; cB = nB; ++ui;
        if (wr == 1) PG8_BAR;
    }
    PG8_WAIT_V(0);
    PG8_BAR;
#undef PG8_SA
#undef PG8_SB
#undef PG8_STAGE
#undef PG8_LDA
#undef PG8_LDB
#undef PG8_MMA
#undef PG8_WAIT_V
#undef PG8_WAIT_L
#undef PG8_BAR
#undef PG8_SCHED
}
}

enum { EM_BF16 = 0, EM_QKV = 1, EM_RES = 2, EM_VMIX = 3, EM_MULZ = 4, EM_GLU = 5 };
struct EpiGen {
    int mode; bf16_t* O; bf16_t* O2; bf16_t* O3; const bf16_t* VFp; const float* f0; const float* f1; float* XL; float* XC; int ldc, nstore, act, k, row_off; unsigned ldsb;
    template <int mode> __device__ __forceinline__ void each(int row, int col, float* v) const {
        if (mode == EM_BF16) {
            if (col >= nstore) return;
            if (act == 1) { for (int i = 0; i < 8; ++i) v[i] = tanhf(v[i]); }
            else if (act == 2) { for (int i = 0; i < 8; ++i) v[i] = sigmoidf_(v[i]); }
            *(u32x4*)(O + (size_t)row * ldc + col) = pack8(v);
        } else if (mode == EM_QKV) {
            const int which = col >> 10, c = col & 1023;
            bf16_t* base = O + (size_t)which * (ABLK / 2);
            const int b = row / PB, p = row - b * PB;
            if (which < 2 && p >= TC) {
                const int t = p - TC; const int g = (c & 63) >> 3;
                const int pos = (g < 4) ? (t >> 6) : (t & 63); const int fo = (g & 3) * 4;
                const f32x4* rp = (const f32x4*)(f0 + (pos * 16 + fo) * 2);
                const f32x4 r0 = rp[0], r1 = rp[1];
                const f32x4 cs = {r0[0], r0[2], r1[0], r1[2]}, sn = {r0[1], r0[3], r1[1], r1[3]};
                const f32x4 t1 = {v[0], v[1], v[2], v[3]}, t2 = {v[4], v[5], v[6], v[7]};
                const f32x4 n1 = t1 * cs - t2 * sn, n2 = t2 * cs + t1 * sn;
                v[0] = n1[0]; v[1] = n1[1]; v[2] = n1[2]; v[3] = n1[3]; v[4] = n2[0]; v[5] = n2[1]; v[6] = n2[2]; v[7] = n2[3];
            }
            *(u32x4*)(base + (size_t)row * DM + c) = pack8(v);
        } else if (mode == EM_RES) {
            const int r = row + row_off; const int b = r / PB, p = r - b * PB;
            float* x; const float* md;
            if (p < TC) { x = XC + ((size_t)(b * TC + p)) * DM + col; md = f0 + (size_t)16 * 6144 + k * DM + col; }
            else { x = XL + ((size_t)(b * TL + p - TC)) * DM + col; md = f0 + (size_t)b * 6144 + k * DM + col; }
            f32x4 x0 = *(f32x4*)x, x1 = *(f32x4*)(x + 4); const f32x4 m0 = *(const f32x4*)md, m1 = *(const f32x4*)(md + 4);
            x0[0] += m0[0] * v[0]; x0[1] += m0[1] * v[1]; x0[2] += m0[2] * v[2]; x0[3] += m0[3] * v[3];
            x1[0] += m1[0] * v[4]; x1[1] += m1[1] * v[5]; x1[2] += m1[2] * v[6]; x1[3] += m1[3] * v[7];
            *(f32x4*)x = x0; *(f32x4*)(x + 4) = x1;
        } else if (mode == EM_VMIX) {
            float a[8], f[8]; unpack8(*(const u32x4*)(O + (size_t)row * DM + col), a); unpack8(*(const u32x4*)(VFp + (size_t)row * DM + col), f);
#pragma unroll
            for (int i = 0; i < 8; ++i) a[i] = a[i] + (f[i] - a[i]) * sigmoidf_(f0[col + i] + v[i]);
            *(u32x4*)(O + (size_t)row * DM + col) = pack8(a);
        } else {
            float a[8]; unpack8(*(const u32x4*)(O + (size_t)row * DM + col), a);
#pragma unroll
            for (int i = 0; i < 8; ++i) a[i] *= v[i];
            *(u32x4*)(O + (size_t)row * DM + col) = pack8(a);
        }
    }
    template <int MODE> __device__ __forceinline__ void run(const f32x4 (&acc)[2][2][4][2], const pg8::Unit& u, int wr, int wc, int fr, int fq) const {
        int fro = fr; asm volatile("" : "+v"(fro));
#pragma unroll
        for (int ai = 0; ai < 2; ++ai)
#pragma unroll
            for (int m = 0; m < 4; ++m) {
                const int row = u.pm * 256 + ai * 128 + wr * 64 + m * 16 + fro;
#pragma unroll
                for (int bj = 0; bj < 2; ++bj) {
                    const int col = u.pn * 256 + bj * 128 + wc * 32 + 8 * fq;
                    float v[8];
                    const f32x4 a0 = acc[ai][bj][m][0], a1 = acc[ai][bj][m][1];
                    v[0] = a0[0]; v[1] = a0[1]; v[2] = a0[2]; v[3] = a0[3]; v[4] = a1[0]; v[5] = a1[1]; v[6] = a1[2]; v[7] = a1[3];
                    each<MODE>(row, col, v);
                }
                asm volatile("" ::: "memory");
            }
    }
    __device__ __forceinline__ void run_glu(const f32x4 (&acc)[2][2][4][2], const pg8::Unit& u, int wr, int wc, int fr, int fq) const {
        LAS float* B = (LAS float*)((LAS unsigned char*)0 + ldsb);
        int fro = fr; asm volatile("" : "+v"(fro));
        int lidx = (wc * 2) * 16 + fq * 4; asm volatile("" : "+v"(lidx));
#pragma unroll
        for (int ai = 0; ai < 2; ++ai)
#pragma unroll
            for (int m = 0; m < 4; ++m) { const int g = ai * 8 + wr * 4 + m;
#pragma unroll
                for (int bj = 0; bj < 2; ++bj) {
                    if (fr == 0) *(LAS f32x4*)(B + (g * 2 + 0) * 128 + lidx + bj * 16) = acc[ai][bj][m][0];
                    if (fr == 15) *(LAS f32x4*)(B + (g * 2 + 1) * 128 + lidx + bj * 16) = acc[ai][bj][m][0];
                } }
        asm volatile("s_waitcnt lgkmcnt(0)" ::: "memory"); __builtin_amdgcn_s_barrier(); asm volatile("" ::: "memory");
        const int t17 = u.pm % 17; const bool tfirst = (t17 == 0) || (t17 == 1), tlast = (t17 == 0) || (t17 == 16);
#pragma unroll
        for (int bj = 0; bj < 2; ++bj) {
            int col = u.pn * 256 + bj * 128 + wc * 32 + 8 * fq; asm volatile("" : "+v"(col)); const int ch = (col >> 3) * 4;
            const f32x4 c0 = *(const f32x4*)(f0 + ch), c1 = *(const f32x4*)(f0 + DFF + ch), c2 = *(const f32x4*)(f0 + 2 * DFF + ch), cb = *(const f32x4*)(f1 + ch);
#pragma unroll
            for (int ai = 0; ai < 2; ++ai)
#pragma unroll
                for (int m = 0; m < 4; ++m) { const int g = ai * 8 + wr * 4 + m;
                    const int row = u.pm * 256 + g * 16 + fro;
                    const f32x4 gt = acc[ai][bj][m][0], vl = acc[ai][bj][m][1];
                    f32x4 gp, gn;
#pragma unroll
                    for (int i = 0; i < 4; ++i) { gp[i] = __int_as_float(__builtin_amdgcn_update_dpp(0, __float_as_int(gt[i]), 0x111, 0xF, 0xF, true));
                                                  gn[i] = __int_as_float(__builtin_amdgcn_update_dpp(0, __float_as_int(gt[i]), 0x101, 0xF, 0xF, true)); }
                    if (fr == 0) {
                        if (g > 0) gp = *(const LAS f32x4*)(B + ((g - 1) * 2 + 1) * 128 + lidx + bj * 16);
                        else if (!tfirst) { const u32x2 w = *(const u32x2*)(VFp + (size_t)(2 * (u.pm - 1)) * (2 * DFF) + col); gp = (f32x4){bflo(w.x), bfhi(w.x), bflo(w.y), bfhi(w.y)}; }
                        else gp = (f32x4){0.f, 0.f, 0.f, 0.f};
                    }
                    if (fr == 15) {
                        if (g < 15) gn = *(const LAS f32x4*)(B + ((g + 1) * 2 + 0) * 128 + lidx + bj * 16);
                        else if (!tlast) { const u32x2 w = *(const u32x2*)(VFp + (size_t)(2 * u.pm + 1) * (2 * DFF) + col); gn = (f32x4){bflo(w.x), bfhi(w.x), bflo(w.y), bfhi(w.y)}; }
                        else gn = (f32x4){0.f, 0.f, 0.f, 0.f};
                    }
                    float o[4];
#pragma unroll
                    for (int i = 0; i < 4; ++i) { const float x = gp[i] * c0[i] + gt[i] * c1[i] + gn[i] * c2[i] + cb[i]; o[i] = x * __builtin_amdgcn_rcpf(1.f + __expf(-x)) * vl[i]; }
                    u32x2 w; w.x = cvt_pk_bf16(o[0], o[1]); w.y = cvt_pk_bf16(o[2], o[3]);
                    *(u32x2*)(O + (size_t)row * DFF + ch) = w;
                    if (m & 1) asm volatile("" ::: "memory");
                }
        }
    }
    __device__ __forceinline__ void operator()(const f32x4 (&acc)[2][2][4][2], const pg8::Unit& u, int wr, int wc, int fr, int fq) const {
        switch (mode) {
        case EM_GLU: run_glu(acc, u, wr, wc, fr, fq); break;
        case EM_BF16: run<EM_BF16>(acc, u, wr, wc, fr, fq); break;
        case EM_QKV: run<EM_QKV>(acc, u, wr, wc, fr, fq); break;
        case EM_RES: run<EM_RES>(acc, u, wr, wc, fr, fq); break;
        case EM_VMIX: run<EM_VMIX>(acc, u, wr, wc, fr, fq); break;
        default: run<EM_MULZ>(acc, u, wr, wc, fr, fq); break;
        }
    }
};

struct TJob { const float* src; bf16_t* dst; int Ksrc, Kdst, Nsrc, Ndst, dld, perm; };
constexpr int MAXJOBS = 48;
struct Params { const float* in[39]; float* out; unsigned char* ws; int njobs; int pad; unsigned ws_lo, ws_hi; TJob jobs[MAXJOBS]; };

constexpr size_t W_QKV(int j) { return (size_t)j * 8 * MiB; }
constexpr size_t W_AO(int j) { return (size_t)j * 8 * MiB + 6 * MiB; }
constexpr size_t W_UP2(int i) { return 16 * MiB + (size_t)i * (33 * MiB / 2); }
constexpr size_t W_DN2(int i) { return W_UP2(i) + 11 * MiB; }
constexpr size_t W_RWB(int j) { return 82 * MiB + (size_t)j * 11 * MiB; }
constexpr size_t RW_R = 0, RW_K = 2 * MiB, RW_V = 4 * MiB, RW_O = 6 * MiB, RW_W1 = 8 * MiB, RW_A1 = RW_W1 + 512 * 1024, RW_G1 = RW_A1 + 512 * 1024, RW_V1 = RW_G1 + 512 * 1024,
                 RW_G2 = 10 * MiB, RW_V2 = RW_G2 + 256 * 1024, RW_W2 = RW_V2 + 256 * 1024, RW_A2 = RW_W2 + 256 * 1024;

__device__ __forceinline__ void p0_transpose_item(const TJob& J, LAS float* scr, int item, int lane) {
    const int nblk = J.Ndst / 32, kb = item / nblk, nb = item % nblk, k0 = 64 * kb, n0 = 32 * nb;
    const int n4 = (lane & 7) * 4, n = n0 + n4;
#pragma unroll
    for (int i = 0; i < 8; ++i) { const int kk = 8 * i + (lane >> 3); const int k = k0 + kk;
        f32x4 val = {0.f, 0.f, 0.f, 0.f}; if (k < J.Ksrc && n < J.Nsrc) val = *(const f32x4*)(J.src + (size_t)k * J.Nsrc + n);
        scr[kk * 33 + n4] = val[0]; scr[kk * 33 + n4 + 1] = val[1]; scr[kk * 33 + n4 + 2] = val[2]; scr[kk * 33 + n4 + 3] = val[3]; }
    asm volatile("s_waitcnt lgkmcnt(0)" ::: "memory");
    const int c = lane & 7;
#pragma unroll
    for (int j = 0; j < 4; ++j) { const int nl = (lane >> 3) + 8 * j; const LAS float* s = scr + (8 * c) * 33 + nl;
        u32x4 o; o.x = cvt_pk_bf16(s[0 * 33], s[1 * 33]); o.y = cvt_pk_bf16(s[2 * 33], s[3 * 33]); o.z = cvt_pk_bf16(s[4 * 33], s[5 * 33]); o.w = cvt_pk_bf16(s[6 * 33], s[7 * 33]);
        int nd = n0 + nl;
        if (J.perm == 1 && nd < 2048) { const int s6 = nd & 63, jj = s6 & 31; nd = (nd & ~63) + 8 * (jj >> 2) + (jj & 3) + ((s6 >> 5) << 2); }
        else if (J.perm == 2) { const int isv = nd >= DFF ? 1 : 0, ch = nd - isv * DFF; nd = (ch >> 2) * 8 + isv * 4 + (ch & 3); }
        *(u32x4*)(J.dst + (size_t)nd * J.dld + k0 + 8 * c) = o; }
    asm volatile("s_waitcnt lgkmcnt(0)" ::: "memory");
}

__device__ __forceinline__ void phase_p0(const Params& P, unsigned char* ws, LAS unsigned char* lds) {
    const int tid = tid_(), lane = tid & 63, wave = __builtin_amdgcn_readfirstlane(tid >> 6);
    const int G = gdim_();
    if (bid_() == 0) {
        for (int i = tid; i < 1024; i += NTHR) { const int pos = i >> 4, f = i & 15; const float inv = powf(10000.f, -(float)f / 16.f); const float ang = (float)pos * inv;
            ((f32x2*)(ws + WS_ROPE))[i] = (f32x2){cosf(ang), sinf(ang)}; }
    }
    {
        LAS float* scr = (LAS float*)(lds + wave * 16384);
        const int gw = bid_() * NWAVES + wave, NGW = G * NWAVES;
        int total = 0;
        for (int j = 0; j < P.njobs; ++j) total += (P.jobs[j].Kdst / 64) * (P.jobs[j].Ndst / 32);
        for (int it = gw; it < total; it += NGW) {
            int r = it, j = 0;
            for (; j < P.njobs; ++j) { const int c = (P.jobs[j].Kdst / 64) * (P.jobs[j].Ndst / 32); if (r < c) break; r -= c; }
            p0_transpose_item(P.jobs[j], scr, r, lane);
        }
    }
    __syncthreads();
    {
        LAS float* SV = (LAS float*)lds;
        LAS float* PART = (LAS float*)(lds + 17 * 4096);
        const float* cin = P.in[1]; const float* cctx = P.in[3];
        for (int i = tid; i < 17 * 1024; i += NTHR) { const int j = i >> 10, k = i & 1023; const float x = (j < 16) ? cin[j * 1024 + k] : cctx[k]; SV[i] = x / (1.f + __expf(-x)); }
        __syncthreads();
        for (int item = bid_(); item < NLAYER * 96; item += G) {
            const int l = item / 96, c0 = (item % 96) * 64;
            const float* W = P.in[4] + (size_t)l * 1024 * 6144 + c0 + lane;
            float acc[17];
#pragma unroll
            for (int j = 0; j < 17; ++j) acc[j] = 0.f;
            const int kbeg = wave * 128;
#pragma unroll 2
            for (int k = kbeg; k < kbeg + 128; ++k) { const float w = W[(size_t)k * 6144];
#pragma unroll
                for (int j = 0; j < 17; ++j) acc[j] += SV[j * 1024 + k] * w; }
#pragma unroll
            for (int j = 0; j < 17; ++j) PART[(wave * 17 + j) * 64 + lane] = acc[j];
            __syncthreads();
            for (int o = tid; o < 17 * 64; o += NTHR) { const int j = o >> 6, cc = o & 63; float s = 0.f;
#pragma unroll
                for (int w = 0; w < 8; ++w) s += PART[(w * 17 + j) * 64 + cc];
                ((float*)(ws + WS_MOD))[((size_t)l * 17 + j) * 6144 + c0 + cc] = s + P.in[5][(size_t)l * 6144 + c0 + cc]; }
            __syncthreads();
        }
    }
}

__device__ __forceinline__ size_t xrow_off(int m, bool& isc, int& key) { const int b = m / PB, p = m - b * PB; isc = p < TC; key = isc ? 16 : b; return isc ? ((size_t)(b * TC + p)) * DM : ((size_t)(b * TL + p - TC)) * DM; }
__device__ __forceinline__ void phase_norm_mod(const float* srcL, const float* srcC, float* cpL, float* cpC, const float* g, const float* mod  , int which, bf16_t* H, bf16_t* HB) {
    const int lane = tid_() & 63, wave = tid_() >> 6;
    const int gw = bid_() * NWAVES + wave, NGW = gdim_() * NWAVES;
    const int rpw = (MR + NGW - 1) / NGW; const int m0 = gw * rpw, m1 = (m0 + rpw < MR) ? (m0 + rpw) : MR;
    if (m0 >= m1) return;
    int curkey = -1; f32x4 gm[4], shv[4], v[4], vn[4], vnn[4];
    { bool isc; int key; const size_t ro = xrow_off(m0, isc, key); const f32x4* src = (const f32x4*)((isc ? srcC : srcL) + ro) + lane;
#pragma unroll
      for (int j = 0; j < 4; ++j) v[j] = src[64 * j]; }
    if (m0 + 1 < m1) { bool isc; int key; const size_t ro = xrow_off(m0 + 1, isc, key); const f32x4* src = (const f32x4*)((isc ? srcC : srcL) + ro) + lane;
#pragma unroll
      for (int j = 0; j < 4; ++j) vn[j] = src[64 * j]; }
    for (int m = m0; m < m1; ++m) {
        if (m + 2 < m1) { bool isc2; int key2; const size_t ro2 = xrow_off(m + 2, isc2, key2); const f32x4* src2 = (const f32x4*)((isc2 ? srcC : srcL) + ro2) + lane;
#pragma unroll
            for (int j = 0; j < 4; ++j) vnn[j] = src2[64 * j]; }
        bool isc; int key; const size_t roff = xrow_off(m, isc, key);
        if (key != curkey) { curkey = key; const float* md = mod + (size_t)key * 6144 + which * 3 * DM;
#pragma unroll
            for (int j = 0; j < 4; ++j) { const int c = 4 * lane + 256 * j; const f32x4 gg = *(const f32x4*)(g + c), sc = *(const f32x4*)(md + DM + c); shv[j] = *(const f32x4*)(md + c);
#pragma unroll
                for (int e = 0; e < 4; ++e) gm[j][e] = gg[e] * (1.f + sc[e]); } }
        float ss = 0.f;
#pragma unroll
        for (int j = 0; j < 4; ++j) ss += (v[j][0] * v[j][0] + v[j][1] * v[j][1]) + (v[j][2] * v[j][2] + v[j][3] * v[j][3]);
        const float rstd = rsqrtf(wave_sum(ss) * (1.f / DM) + 1e-6f);
        if (cpL) { f32x4* dst = (f32x4*)((isc ? cpC : cpL) + roff) + lane;
#pragma unroll
            for (int j = 0; j < 4; ++j) dst[64 * j] = v[j]; }
#pragma unroll
        for (int j = 0; j < 4; ++j) { const int c = 4 * lane + 256 * j;
            float o[4];
#pragma unroll
            for (int e = 0; e < 4; ++e) o[e] = v[j][e] * rstd * gm[j][e] + shv[j][e];
            u32x2 w; w.x = cvt_pk_bf16(o[0], o[1]); w.y = cvt_pk_bf16(o[2], o[3]);
            *(u32x2*)(H + (size_t)m * DM + c) = w;
            if (HB) { const int tm = m >> 8, rm = m & 255;
                if (rm == 255) *(u32x2*)(HB + (size_t)(2 * tm) * DM + c) = w;
                else if (rm == 0 && tm > 0) *(u32x2*)(HB + (size_t)(2 * (tm - 1) + 1) * DM + c) = w; } }
#pragma unroll
        for (int j = 0; j < 4; ++j) { v[j] = vn[j]; vn[j] = vnn[j]; }
    }
}
__device__ __forceinline__ void phase_final_norm(float* X, const float* g) {
    const int lane = tid_() & 63, wave = tid_() >> 6;
    const int gw = bid_() * NWAVES + wave, NGW = gdim_() * NWAVES;
    const int NR = NB * TL; const int rpw = (NR + NGW - 1) / NGW; const int m0 = gw * rpw, m1 = (m0 + rpw < NR) ? (m0 + rpw) : NR;
    if (m0 >= m1) return;
    f32x4 gg[4], v[4], vn[4];
#pragma unroll
    for (int j = 0; j < 4; ++j) { gg[j] = *(const f32x4*)(g + 4 * lane + 256 * j); v[j] = ((const f32x4*)(X + (size_t)m0 * DM) + lane)[64 * j]; }
    for (int m = m0; m < m1; ++m) {
        if (m + 1 < m1) { const f32x4* s2 = (const f32x4*)(X + (size_t)(m + 1) * DM) + lane;
#pragma unroll
            for (int j = 0; j < 4; ++j) vn[j] = s2[64 * j]; }
        float ss = 0.f;
#pragma unroll
        for (int j = 0; j < 4; ++j) ss += (v[j][0] * v[j][0] + v[j][1] * v[j][1]) + (v[j][2] * v[j][2] + v[j][3] * v[j][3]);
        const float rstd = rsqrtf(wave_sum(ss) * (1.f / DM) + 1e-6f);
        f32x4* dst = (f32x4*)(X + (size_t)m * DM) + lane;
#pragma unroll
        for (int j = 0; j < 4; ++j) { f32x4 o;
#pragma unroll
            for (int e = 0; e < 4; ++e) o[e] = v[j][e] * rstd * gg[j][e];
            dst[64 * j] = o; }
#pragma unroll
        for (int j = 0; j < 4; ++j) v[j] = vn[j];
    }
}
__device__ __forceinline__ void phase_mix(const bf16_t* H, const float* mp, const float* mn, int ma, int mb, bf16_t* OA, bf16_t* OB, const bf16_t* Kt, const float* kk_w, float* KN) {
    const int lane = tid_() & 63, wave = tid_() >> 6;
    const int gw = bid_() * NWAVES + wave, NGW = gdim_() * NWAVES;
    const int rpw = (MR + NGW - 1) / NGW; const int m0 = gw * rpw, m1 = (m0 + rpw < MR) ? (m0 + rpw) : MR;
    if (m0 >= m1) return;
    const int c0 = lane * 16;
    float pa[16], na[16], pb[16], nb[16];
#pragma unroll
    for (int i = 0; i < 16; ++i) { pa[i] = mp[ma * DM + c0 + i]; na[i] = mn[ma * DM + c0 + i]; pb[i] = mp[mb * DM + c0 + i]; nb[i] = mn[mb * DM + c0 + i]; }
    float kw[16];
#pragma unroll
    for (int i = 0; i < 16; ++i) kw[i] = KN ? kk_w[c0 + i] : 0.f;
    const u32x4 z4 = {0u, 0u, 0u, 0u};
    u32x4 P0 = z4, P1 = z4, C0, C1, N0 = z4, N1 = z4, NN0 = z4, NN1 = z4, K0 = z4, K1 = z4, KN0 = z4, KN1 = z4;
    { const u32x4* q = (const u32x4*)(H + (size_t)m0 * DM + c0); C0 = q[0]; C1 = q[1]; }
    if (m0 > 0) { const u32x4* q = (const u32x4*)(H + (size_t)(m0 - 1) * DM + c0); P0 = q[0]; P1 = q[1]; }
    if (m0 + 1 < MR) { const u32x4* q = (const u32x4*)(H + (size_t)(m0 + 1) * DM + c0); N0 = q[0]; N1 = q[1]; }
    if (KN) { const u32x4* kr = (const u32x4*)(Kt + (size_t)m0 * DM + c0); K0 = kr[0]; K1 = kr[1]; }
    for (int m = m0; m < m1; ++m) {
        if (m + 2 < MR && m + 1 < m1) { const u32x4* q = (const u32x4*)(H + (size_t)(m + 2) * DM + c0); NN0 = q[0]; NN1 = q[1]; }
        if (KN && m + 1 < m1) { const u32x4* kr = (const u32x4*)(Kt + (size_t)(m + 1) * DM + c0); KN0 = kr[0]; KN1 = kr[1]; }
        const int b = m / PB, p = m - b * PB;
        const bool first = (p == 0) || (p == TC), lastr = (p == TC - 1) || (p == PB - 1);
        float h[16], hp[16], hn[16];
        unpack8(C0, h); unpack8(C1, h + 8);
        unpack8(first ? z4 : P0, hp); unpack8(first ? z4 : P1, hp + 8);
        unpack8(lastr ? z4 : N0, hn); unpack8(lastr ? z4 : N1, hn + 8);
        float oa[16], ob[16];
#pragma unroll
        for (int i = 0; i < 16; ++i) { const float dp = hp[i] - h[i], dn = hn[i] - h[i];
            oa[i] = h[i] + dp * pa[i] + dn * na[i];
            ob[i] = h[i] + dp * pb[i] + dn * nb[i]; }
        u32x4* da = (u32x4*)(OA + (size_t)m * DM + c0); da[0] = pack8(oa); da[1] = pack8(oa + 8);
        u32x4* db = (u32x4*)(OB + (size_t)m * DM + c0); db[0] = pack8(ob); db[1] = pack8(ob + 8);
        if (KN) {
            float kv[16]; unpack8(K0, kv); unpack8(K1, kv + 8);
            float ss = 0.f;
#pragma unroll
            for (int i = 0; i < 16; ++i) { const float t = kv[i] * kw[i]; ss += t * t; }
            ss = red4(ss);
            if ((lane & 3) == 0) KN[(size_t)m * 16 + (lane >> 2)] = 1.f / fmaxf(sqrtf(ss), 1e-12f);
        }
        P0 = C0; P1 = C1; C0 = N0; C1 = N1; N0 = NN0; N1 = NN1; K0 = KN0; K1 = KN1;
    }
}
__device__ __forceinline__ void phase_convact(const bf16_t* GV, bf16_t* ACT, int rows, int row_off, const float* cw, const float* cb) {
    const size_t nitem = (size_t)rows * 352;
    for (size_t it = (size_t)bid_() * NTHR + tid_(); it < nitem; it += (size_t)gdim_() * NTHR) {
        const int r = (int)(it / 352), cg8 = (int)(it - (size_t)r * 352), n0 = cg8 * 8;
        const int gr = r + row_off; const int b = gr / PB, p = gr - b * PB;
        const bool first = (p == 0) || (p == TC), lastr = (p == TC - 1) || (p == PB - 1);
        const bf16_t* base = GV + (size_t)r * 5632 + n0;
        float g[8], gp[8], gn[8], vv[8];
        unpack8(*(const u32x4*)base, g); unpack8(*(const u32x4*)(base + DFF), vv);
        if (!first) unpack8(*(const u32x4*)(base - 5632), gp); else { for (int i = 0; i < 8; ++i) gp[i] = 0.f; }
        if (!lastr) unpack8(*(const u32x4*)(base + 5632), gn); else { for (int i = 0; i < 8; ++i) gn[i] = 0.f; }
        float o[8];
#pragma unroll
        for (int i = 0; i < 8; ++i) { const float x = gp[i] * cw[n0 + i] + g[i] * cw[DFF + n0 + i] + gn[i] * cw[2 * DFF + n0 + i] + cb[n0 + i];
            o[i] = x / (1.f + __expf(-x)) * vv[i]; }
        *(u32x4*)(ACT + (size_t)r * DFF + n0) = pack8(o);
    }
}
__device__ __forceinline__ void phase_post(const bf16_t* Y0, const bf16_t* Y1, const bf16_t* V, const float* CB, const float* lg, const float* lb, bf16_t* Z) {
    const int lane = tid_() & 63, wave = tid_() >> 6;
    const int gw = bid_() * NWAVES + wave, NGW = gdim_() * NWAVES;
    const int rpw = (MR + NGW - 1) / NGW; const int m0 = gw * rpw, m1 = (m0 + rpw < MR) ? (m0 + rpw) : MR;
    const int c0 = lane * 16, hd = lane >> 2;
    float lgv[16], lbv[16];
#pragma unroll
    for (int i = 0; i < 16; ++i) { lgv[i] = lg[c0 + i]; lbv[i] = lb[c0 + i]; }
    if (m0 >= m1) return;
    u32x4 ya0, ya1, yb0, yb1, vv0, vv1, na0, na1, nb0, nb1, nv0, nv1;
    { const u32x4* q = (const u32x4*)(Y0 + (size_t)m0 * DM + c0); ya0 = q[0]; ya1 = q[1]; q = (const u32x4*)(Y1 + (size_t)m0 * DM + c0); yb0 = q[0]; yb1 = q[1]; q = (const u32x4*)(V + (size_t)m0 * DM + c0); vv0 = q[0]; vv1 = q[1]; }
    na0 = ya0; na1 = ya1; nb0 = yb0; nb1 = yb1; nv0 = vv0; nv1 = vv1;
    for (int m = m0; m < m1; ++m) {
        if (m + 1 < m1) { const u32x4* q = (const u32x4*)(Y0 + (size_t)(m + 1) * DM + c0); na0 = q[0]; na1 = q[1]; q = (const u32x4*)(Y1 + (size_t)(m + 1) * DM + c0); nb0 = q[0]; nb1 = q[1]; q = (const u32x4*)(V + (size_t)(m + 1) * DM + c0); nv0 = q[0]; nv1 = q[1]; }
        float a[16], b2[16], vv[16];
        unpack8(ya0, a); unpack8(ya1, a + 8); unpack8(yb0, b2); unpack8(yb1, b2 + 8); unpack8(vv0, vv); unpack8(vv1, vv + 8);
        ya0 = na0; ya1 = na1; yb0 = nb0; yb1 = nb1; vv0 = nv0; vv1 = nv1;
        float s = 0.f;
#pragma unroll
        for (int i = 0; i < 16; ++i) { a[i] += b2[i]; s += a[i]; }
        s = red4(s); const float mu = s * (1.f / 64.f); float q2 = 0.f;
#pragma unroll
        for (int i = 0; i < 16; ++i) { a[i] -= mu; q2 += a[i] * a[i]; }
        q2 = red4(q2); const float rs = rsqrtf(q2 * (1.f / 64.f) + 64e-5f);
        const float bon = CB[(size_t)m * 16 + hd] + CB[(size_t)MR * 16 + (size_t)m * 16 + hd];
        float o[16];
#pragma unroll
        for (int i = 0; i < 16; ++i) o[i] = a[i] * rs * lgv[i] + lbv[i] + bon * vv[i];
        u32x4* d = (u32x4*)(Z + (size_t)m * DM + c0); d[0] = pack8(o); d[1] = pack8(o + 8);
    }
}

namespace att {
constexpr int KVBLK = 64, LD = 1024;
constexpr float SCALE = 0.125f;
constexpr float THR = 8.f;
constexpr size_t SHM_V = KVBLK * 128 * 2, SHM_K = KVBLK * 128 * 2;
#define KSWZ(row, colB) ((row) * 256 + ((colB) ^ (((row) & 7) << 4)))
#define SBAR() __builtin_amdgcn_sched_barrier(0)
__device__ __forceinline__ int crow(int r, int hi) { return (r & 3) + 8 * (r >> 2) + 4 * hi; }
__device__ __forceinline__ void partialSM(f32x16& p0, f32x16& p1, float& m_reg, float& mn, float& alpha) {
    constexpr float C = SCALE * 1.4426950408889634f;
    float pmax = p0[0];
#pragma unroll
    for (int r = 1; r < 16; ++r) pmax = fmaxf(pmax, p0[r]);
#pragma unroll
    for (int r = 0; r < 16; ++r) pmax = fmaxf(pmax, p1[r]);
    { auto rr = __builtin_amdgcn_permlane32_swap(__float_as_uint(pmax), __float_as_uint(pmax), false, false);
      pmax = fmaxf(__uint_as_float(rr[0]), __uint_as_float(rr[1])); }
    if (__builtin_expect(__all(pmax - m_reg <= THR / SCALE), 1)) { mn = m_reg; alpha = 1.f; }
    else { mn = fmaxf(m_reg, pmax); alpha = __builtin_amdgcn_exp2f((m_reg - mn) * C); m_reg = mn; }
    const float mnC = -mn * C;
#pragma unroll
    for (int r = 0; r < 16; ++r) p0[r] = fmaf(p0[r], C, mnC);
#pragma unroll
    for (int r = 0; r < 16; ++r) p1[r] = fmaf(p1[r], C, mnC);
#pragma unroll
    for (int r = 0; r < 16; ++r) p0[r] = __builtin_amdgcn_exp2f(p0[r]);
}
__device__ __forceinline__ void finishSM(f32x16& p0, f32x16& p1, float alpha, float& l_reg, bf16x8& pa0, bf16x8& pa1, bf16x8& pa2, bf16x8& pa3) {
#pragma unroll
    for (int r = 0; r < 16; ++r) p1[r] = __builtin_amdgcn_exp2f(p1[r]);
    float ps = 0;
#pragma unroll
    for (int r = 0; r < 16; ++r) ps += p0[r];
#pragma unroll
    for (int r = 0; r < 16; ++r) ps += p1[r];
    { auto rr = __builtin_amdgcn_permlane32_swap(__float_as_uint(ps), __float_as_uint(ps), false, false);
      ps = __uint_as_float(rr[0]) + __uint_as_float(rr[1]); }
    l_reg = l_reg * alpha + ps;
#define PK4(P, BASE, OUT) do { unsigned a0 = cvt_pk_bf16(P[BASE + 0], P[BASE + 1]), a1 = cvt_pk_bf16(P[BASE + 2], P[BASE + 3]);   \
    unsigned b0 = cvt_pk_bf16(P[BASE + 4], P[BASE + 5]), b1 = cvt_pk_bf16(P[BASE + 6], P[BASE + 7]);                              \
    auto r0 = __builtin_amdgcn_permlane32_swap(a0, b0, false, false); auto r1 = __builtin_amdgcn_permlane32_swap(a1, b1, false, false); \
    u32x4 w = {r0[0], r1[0], r0[1], r1[1]}; OUT = *reinterpret_cast<bf16x8*>(&w); } while (0)
    PK4(p0, 0, pa0); PK4(p0, 8, pa1); PK4(p1, 0, pa2); PK4(p1, 8, pa3);
#undef PK4
}
__device__ __forceinline__ void qkt(f32x16& p0, f32x16& p1, const char* Ks, const bf16x8* qr, int r32, int hi, int comp) {
    p0 = f32x16{}; p1 = f32x16{};
#pragma unroll
    for (int d0 = 0; d0 < 4; ++d0) { const int cb = (comp * 64 + d0 * 16 + hi * 8) * 2;
        const bf16x8 b0 = *reinterpret_cast<const bf16x8*>(Ks + KSWZ(r32, cb));
        const bf16x8 b1 = *reinterpret_cast<const bf16x8*>(Ks + KSWZ(32 + r32, cb));
        p0 = __builtin_amdgcn_mfma_f32_32x32x16_bf16(b0, qr[d0], p0, 0, 0, 0);
        p1 = __builtin_amdgcn_mfma_f32_32x32x16_bf16(b1, qr[d0], p1, 0, 0, 0); }
}
__device__ __forceinline__ int v_st(int k, int c) { const int kk = (k & ~0xC) | ((k & 4) << 1) | ((k & 8) >> 1); return ((kk >> 3) * 4 + (c >> 5)) * 512 + ((kk & 7) * 32 + (c & 31)) * 2; }
__device__ __forceinline__ int v_rd_base(int lane) { return ((lane & 3) << 3) | (((lane >> 2) & 3) << 6) | (((lane >> 4) & 1) << 5) | (((lane >> 5) & 1) << 8); }
constexpr int v_rd_off(int d0, int ks, int half) { return d0 * 512 + ks * 4096 + half * 2048; }
template <int OFF> __device__ __forceinline__ s16x4 tr_read(int vb) {
    s16x4 r; asm volatile("ds_read_b64_tr_b16 %0, %1 offset:%2" : "=&v"(r) : "v"(vb), "i"(OFF) : "memory"); return r;
}
template <int D0> __device__ __forceinline__ void pv_one(f32x16& od, int vb, bf16x8 pa0, bf16x8 pa1, bf16x8 pa2, bf16x8 pa3) {
    const s16x4 l0 = tr_read<v_rd_off(D0, 0, 0)>(vb), h0 = tr_read<v_rd_off(D0, 0, 1)>(vb), l1 = tr_read<v_rd_off(D0, 1, 0)>(vb), h1 = tr_read<v_rd_off(D0, 1, 1)>(vb);
    const s16x4 l2 = tr_read<v_rd_off(D0, 2, 0)>(vb), h2 = tr_read<v_rd_off(D0, 2, 1)>(vb), l3 = tr_read<v_rd_off(D0, 3, 0)>(vb), h3 = tr_read<v_rd_off(D0, 3, 1)>(vb);
    asm volatile("s_waitcnt lgkmcnt(0)" ::: "memory"); SBAR();
#define PK(L, H) (bf16x8){L[0], L[1], L[2], L[3], H[0], H[1], H[2], H[3]}
    od = __builtin_amdgcn_mfma_f32_32x32x16_bf16(pa0, PK(l0, h0), od, 0, 0, 0);
    od = __builtin_amdgcn_mfma_f32_32x32x16_bf16(pa1, PK(l1, h1), od, 0, 0, 0);
    od = __builtin_amdgcn_mfma_f32_32x32x16_bf16(pa2, PK(l2, h2), od, 0, 0, 0);
    od = __builtin_amdgcn_mfma_f32_32x32x16_bf16(pa3, PK(l3, h3), od, 0, 0, 0);
#undef PK
}
__device__ __forceinline__ void pv_d0(f32x16* o, int vb, bf16x8 pa0, bf16x8 pa1, bf16x8 pa2, bf16x8 pa3) {
    pv_one<0>(o[0], vb, pa0, pa1, pa2, pa3); pv_one<1>(o[1], vb, pa0, pa1, pa2, pa3); pv_one<2>(o[2], vb, pa0, pa1, pa2, pa3); pv_one<3>(o[3], vb, pa0, pa1, pa2, pa3);
}
__device__ __forceinline__ void attn_unit(const bf16_t* Qb, const bf16_t* Kh, const bf16_t* Vh, bf16_t* Ob, float* scr, int seq, float lam, float onemli, const float* subg, char* lds) {
    const int tid = tid_(), wid = tid >> 6, lane = tid & 63, r32 = lane & 31, hi = lane >> 5;
    char* V_lds = lds; char* K_lds = lds + 2 * SHM_V;
    float* wsl = (float*)(lds + 2 * SHM_V + 2 * SHM_K) + wid * 64; float* li_l = wsl; float* al_l = wsl + 32;
    const int sr = tid >> 4, sc = (tid & 15) * 8, vst0 = v_st(sr, sc), vst1 = v_st(32 + sr, sc);
    const unsigned kvoff = (unsigned)(sr * LD + sc) * 2u;
    const int vb0 = (int)(uintptr_t)V_lds + v_rd_base(lane);
    const int NT = seq / KVBLK;
#pragma unroll
    for (int comp = 0; comp < 2; ++comp) {
        float m_reg = -1e30f, l_reg = 0; f32x16 o[4] = {}; bf16x8 qr[4];
        const unsigned qoff = (unsigned)((wid * 32 + r32) * LD + comp * 64 + hi * 8) * 2u;
#pragma unroll
        for (int d0 = 0; d0 < 4; ++d0) qr[d0] = *reinterpret_cast<const bf16x8*>((const char*)Qb + qoff + d0 * 32);
        struct { bf16x8 vs0, vs1, ks0, ks1; } sr_[1];
#define SLOAD(i, k0) do { const unsigned o0_ = kvoff + (unsigned)(k0) * (LD * 2), o1_ = o0_ + 32 * LD * 2; \
    sr_[i].vs0 = *reinterpret_cast<const bf16x8*>((const char*)Vh + o0_); sr_[i].vs1 = *reinterpret_cast<const bf16x8*>((const char*)Vh + o1_); \
    sr_[i].ks0 = *reinterpret_cast<const bf16x8*>((const char*)Kh + o0_); sr_[i].ks1 = *reinterpret_cast<const bf16x8*>((const char*)Kh + o1_); } while (0)
#define SWRITE(b, i) do { *(bf16x8*)(V_lds + (b) * SHM_V + vst0) = sr_[i].vs0;          \
    *(bf16x8*)(V_lds + (b) * SHM_V + vst1) = sr_[i].vs1; int kc = sc * 2;               \
    *(bf16x8*)(K_lds + (b) * SHM_K + KSWZ(sr, kc)) = sr_[i].ks0;                       \
    *(bf16x8*)(K_lds + (b) * SHM_K + KSWZ(32 + sr, kc)) = sr_[i].ks1; } while (0)
#define SWAIT() asm volatile("s_waitcnt vmcnt(0)" ::: "memory")
#define RESC(a) do { if (__any((a) < 1.f)) { if (hi == 0) al_l[r32] = (a); asm volatile("s_waitcnt lgkmcnt(0)" ::: "memory"); \
    _Pragma("unroll") for (int d = 0; d < 4; ++d) _Pragma("unroll") for (int r = 0; r < 16; ++r) o[d][r] *= al_l[crow(r, hi)]; } } while (0)
        f32x16 pA0, pA1, pB0, pB1; float mnA, mnB, alA, alB; bf16x8 pa0, pa1, pa2, pa3;
        constexpr int SE = 0, SO = 0;
        __syncthreads();
        SLOAD(SE, 0); asm volatile("s_waitcnt vmcnt(0)" ::: "memory"); SWRITE(0, SE); __syncthreads();
        qkt(pA0, pA1, K_lds, qr, r32, hi, comp); partialSM(pA0, pA1, m_reg, mnA, alA);
        SLOAD(SO, KVBLK);
        SWAIT(); SWRITE(1, SO); __syncthreads();
        for (int j = 1; j + 1 < NT; j += 2) {
            SBAR(); qkt(pB0, pB1, K_lds + SHM_K, qr, r32, hi, comp);
            finishSM(pA0, pA1, alA, l_reg, pa0, pa1, pa2, pa3); SBAR();
            SLOAD(SO, (j + 1) * KVBLK); SBAR();
            pv_d0(o, vb0, pa0, pa1, pa2, pa3); partialSM(pB0, pB1, m_reg, mnB, alB);
            __syncthreads(); SWAIT(); SWRITE(0, SE);
            RESC(alB); __syncthreads();
            SBAR(); qkt(pA0, pA1, K_lds, qr, r32, hi, comp);
            finishSM(pB0, pB1, alB, l_reg, pa0, pa1, pa2, pa3); SBAR();
            SLOAD(SE, (j + 2) * KVBLK); SBAR();
            pv_d0(o, vb0 + (int)SHM_V, pa0, pa1, pa2, pa3); partialSM(pA0, pA1, m_reg, mnA, alA);
            __syncthreads(); SWAIT(); SWRITE(1, SO);
            RESC(alA); __syncthreads();
        }
        SBAR(); qkt(pB0, pB1, K_lds + SHM_K, qr, r32, hi, comp);
        finishSM(pA0, pA1, alA, l_reg, pa0, pa1, pa2, pa3); SBAR();
        pv_d0(o, vb0, pa0, pa1, pa2, pa3); partialSM(pB0, pB1, m_reg, mnB, alB);
        __syncthreads(); RESC(alB);
        finishSM(pB0, pB1, alB, l_reg, pa0, pa1, pa2, pa3); SBAR();
        pv_d0(o, vb0 + (int)SHM_V, pa0, pa1, pa2, pa3);
        if (hi == 0) li_l[r32] = l_reg; asm volatile("s_waitcnt lgkmcnt(0)" ::: "memory");
        float rli[16];
#pragma unroll
        for (int r = 0; r < 16; ++r) rli[r] = __builtin_amdgcn_rcpf(li_l[crow(r, hi)]);
        unsigned soff = (unsigned)((wid * 64 + lane) * 256); asm volatile("" : "+v"(soff));
        f32x4* sw = (f32x4*)((char*)scr + soff);
        if (comp == 0) {
#pragma unroll
            for (int d0 = 0; d0 < 4; ++d0)
#pragma unroll
                for (int r = 0; r < 16; r += 4) sw[d0 * 4 + (r >> 2)] = (f32x4){o[d0][r] * rli[r], o[d0][r + 1] * rli[r + 1], o[d0][r + 2] * rli[r + 2], o[d0][r + 3] * rli[r + 3]};
        } else {
            float ssq[16];
#pragma unroll
            for (int r = 0; r < 16; ++r) ssq[r] = 0.f;
#pragma unroll
            for (int d0 = 0; d0 < 4; ++d0) {
#pragma unroll
                for (int r4 = 0; r4 < 4; ++r4) { const f32x4 pv = sw[d0 * 4 + r4];
#pragma unroll
                    for (int e = 0; e < 4; ++e) { const int r = r4 * 4 + e; const float x = pv[e] - lam * (o[d0][r] * rli[r]); o[d0][r] = x; ssq[r] += x * x; } }
                asm volatile("" ::: "memory");
            }
#pragma unroll
            for (int r = 0; r < 16; ++r) {
                float s = ssq[r];
                s += __shfl_xor(s, 1); s += __shfl_xor(s, 2); s += __shfl_xor(s, 4); s += __shfl_xor(s, 8); s += __shfl_xor(s, 16);
                ssq[r] = rsqrtf(s * (1.f / 128.f) + 1e-6f) * onemli;
            }
            float sg[4];
#pragma unroll
            for (int d0 = 0; d0 < 4; ++d0) sg[d0] = subg[d0 * 32 + r32];
            char* stg = lds + 67584 + wid * 8704;
            unsigned sbase = (unsigned)((4 * hi) * 272 + r32 * 2); asm volatile("" : "+v"(sbase));
#pragma unroll
            for (int r = 0; r < 16; ++r) { const int orow = (r & 3) + 8 * (r >> 2);
#pragma unroll
                for (int d0 = 0; d0 < 4; ++d0) { const unsigned w = cvt_pk_bf16(o[d0][r] * ssq[r] * sg[d0], 0.f); *(bf16_t*)(stg + sbase + orow * 272 + d0 * 64) = (bf16_t)(w & 0xffffu); } }
            asm volatile("s_waitcnt lgkmcnt(0)" ::: "memory");
            unsigned rdo = (unsigned)((lane >> 4) * 272 + (lane & 15) * 16); asm volatile("" : "+v"(rdo));
            unsigned gwo = (unsigned)(((wid * 32 + (lane >> 4)) * LD + (lane & 15) * 8) * 2); asm volatile("" : "+v"(gwo));
#pragma unroll
            for (int it = 0; it < 8; ++it) { const u32x4 w = *(const u32x4*)(stg + rdo + it * 4 * 272); *(u32x4*)((char*)Ob + gwo + it * 4 * LD * 2) = w; }
            asm volatile("s_waitcnt lgkmcnt(0)" ::: "memory");
        }
#undef SLOAD
#undef SWRITE
#undef SWAIT
#undef RESC
    }
}
}

__device__ __forceinline__ void phase_attn(const bf16_t* Q, const bf16_t* K, const bf16_t* V, bf16_t* O, float* scr_all, const float* lamv, float lambda_init, const float* subg, char* lds) {
    float s01 = 0.f, s23 = 0.f;
    for (int i = 0; i < 64; ++i) { s01 += lamv[i] * lamv[64 + i]; s23 += lamv[128 + i] * lamv[192 + i]; }
    const float lam = __expf(s01) - __expf(s23) + lambda_init;
    const float onemli = 1.f - lambda_init;
    float* scr = scr_all + (size_t)bid_() * 32768;
    const int G = gdim_(), blk = bid_();
    const int NU = NB * 8 * 16 + NB * 8;
    for (int i = 0;; ++i) {
        int u = i * G + blk; if (u >= NU) break;
        int pair, qb; bool isctx = false;
        if (u < 2048) {
            if (G == 256) { const int x = blk & 7, vb = blk >> 3; pair = i * 16 + 2 * x + (vb >> 4); qb = vb & 15; }
            else { pair = u >> 4; qb = u & 15; }
        } else { pair = u - 2048; qb = 0; isctx = true; }
        const int b = pair >> 3, h = pair & 7;
        const size_t rb = (size_t)b * PB;
        const size_t qrow = rb + (isctx ? 0 : (TC + qb * 256));
        att::attn_unit(Q + qrow * DM + h * 128, K + rb * DM + h * 128, V + rb * DM + h * 128, O + qrow * DM + h * 128, scr, isctx ? TC : PB, lam, onemli, subg, lds);
    }
}

struct ScanArgs { const bf16_t *R, *K, *V, *WL, *AL; const float* KN; const bf16_t *W2T, *A2T; const float *w0, *a0, *k_k, *k_a, *r_k; bf16_t *Y0, *Y1; float* CB; };
__device__ __forceinline__ int scan_row(int dir, int s) { return dir == 0 ? s : (s < TC ? (TC - 1 - s) : (PB + TC - 1 - s)); }

struct ScanRaw { bf16x8 aw[2], aa[2]; unsigned kv[2][4], rv[2][4], vv[2][4]; float knv[4]; };
__device__ __forceinline__ void scan_issue(const ScanArgs& A, int dir, int b, int h, int nbh, int chunk, int lane, ScanRaw& R) {
    const int kq = lane >> 4, l16 = lane & 15;
    const int s0 = chunk * 16;
    const size_t mA = (size_t)b * PB + scan_row(dir, s0 + l16);
#pragma unroll
    for (int ks = 0; ks < 2; ++ks) { R.aw[ks] = *(const bf16x8*)(A.WL + mA * 128 + dir * 64 + ks * 32 + kq * 8); R.aa[ks] = *(const bf16x8*)(A.AL + mA * 128 + dir * 64 + ks * 32 + kq * 8); }
#pragma unroll
    for (int i = 0; i < 4; ++i) { const unsigned mrow = (unsigned)(b * PB + scan_row(dir, s0 + kq * 4 + i)); R.knv[i] = A.KN[(size_t)mrow * 16 + h];
#pragma unroll
        for (int nb2 = 0; nb2 < 2; ++nb2) { const int n = (nbh * 2 + nb2) * 16 + l16; const unsigned g = (mrow * DM + h * 64 + n) * 2u;
            R.kv[nb2][i] = *(const bf16_t*)((const char*)A.K + g); R.rv[nb2][i] = *(const bf16_t*)((const char*)A.R + g); R.vv[nb2][i] = *(const bf16_t*)((const char*)A.V + g); } }
}
__device__ __forceinline__ void scan_process(const ScanRaw& R, int nbh, LAS float* IN, LAS float* BON, int lane,
                                             const bf16x8 (&w2b)[2][2], const bf16x8 (&a2b)[2][2], const float (&w0v)[2], const float (&a0v)[2], const float (&kkv)[2], const float (&kav)[2], const float (&rkv)[2]) {
    const int kq = lane >> 4, l16 = lane & 15;
    float bon[4] = {0.f, 0.f, 0.f, 0.f};
#pragma unroll
    for (int nb2 = 0; nb2 < 2; ++nb2) {
        const int nb = nbh * 2 + nb2; const int n = nb * 16 + l16;
        f32x4 accw = {0.f, 0.f, 0.f, 0.f}, acca = {0.f, 0.f, 0.f, 0.f};
        accw = __builtin_amdgcn_mfma_f32_16x16x32_bf16(R.aw[0], w2b[0][nb2], accw, 0, 0, 0);
        accw = __builtin_amdgcn_mfma_f32_16x16x32_bf16(R.aw[1], w2b[1][nb2], accw, 0, 0, 0);
        acca = __builtin_amdgcn_mfma_f32_16x16x32_bf16(R.aa[0], a2b[0][nb2], acca, 0, 0, 0);
        acca = __builtin_amdgcn_mfma_f32_16x16x32_bf16(R.aa[1], a2b[1][nb2], acca, 0, 0, 0);
#pragma unroll
        for (int i = 0; i < 4; ++i) {
            const int tp = kq * 4 + i;
            const float kv = __uint_as_float(R.kv[nb2][i] << 16), rv = __uint_as_float(R.rv[nb2][i] << 16), vv = __uint_as_float(R.vv[nb2][i] << 16);
            const float win = w0v[nb2] + accw[i];
            const float decay = __expf(-0.6065306597126334f * sigmoidf_(win));
            const float a = sigmoidf_(a0v[nb2] + acca[i]);
            const float kk = kv * kkv[nb2] * R.knv[i];
            const float kd = kv * (1.f + (a - 1.f) * kav[nb2]);
            bon[i] += rv * kd * rkv[nb2];
            LAS float* d = IN + tp * 64 + n;
            d[0 * 1024] = decay; d[1 * 1024] = kd; d[2 * 1024] = kk * a; d[3 * 1024] = -kk; d[4 * 1024] = rv; d[5 * 1024] = vv;
        }
    }
#pragma unroll
    for (int i = 0; i < 4; ++i) { const float s = red16(bon[i]); if (l16 == 0) BON[nbh * 16 + kq * 4 + i] = s; }
}

__device__ __forceinline__ void phase_scan(const ScanArgs A, LAS unsigned char* lds) {
    const int tid = tid_(), lane = tid & 63, wave = __builtin_amdgcn_readfirstlane(tid >> 6);
    constexpr int NCH = PB / 16;
    for (int cp = bid_(); cp < 256; cp += gdim_()) {
        const int dir = cp >> 7, rem = cp & 127, b = rem >> 3, h0 = (rem & 7) * 2;
        const bool consumer = wave < 4;
        const int chain = consumer ? (wave >> 1) : ((wave - 4) >> 1);
        const int half = wave & 1;
        const int h = h0 + chain;
        LAS float* INc = (LAS float*)(lds + chain * 49152);
        LAS float* YBc = (LAS float*)(lds + 98304 + chain * 8192);
        LAS float* BONc = (LAS float*)(lds + 114688 + chain * 512);
        bf16_t* Yd = dir == 0 ? A.Y0 : A.Y1;
        bf16x8 w2b[2][2], a2b[2][2]; float w0v[2], a0v[2], kkv[2], kav[2], rkv[2];
        if (!consumer) {
            const int kq = lane >> 4, l16 = lane & 15;
#pragma unroll
            for (int nb2 = 0; nb2 < 2; ++nb2) { const int n = h * 64 + (half * 2 + nb2) * 16 + l16;
#pragma unroll
                for (int ks = 0; ks < 2; ++ks) { w2b[ks][nb2] = *(const bf16x8*)(A.W2T + ((size_t)dir * DM + n) * 64 + ks * 32 + kq * 8); a2b[ks][nb2] = *(const bf16x8*)(A.A2T + ((size_t)dir * DM + n) * 64 + ks * 32 + kq * 8); }
                w0v[nb2] = A.w0[dir * DM + n]; a0v[nb2] = A.a0[dir * DM + n]; kkv[nb2] = A.k_k[n]; kav[nb2] = A.k_a[n]; rkv[nb2] = A.r_k[n]; }
        }
        f32x2 S2[2][8];
#pragma unroll
        for (int i = 0; i < 2; ++i)
#pragma unroll
            for (int p = 0; p < 8; ++p) S2[i][p] = (f32x2){0.f, 0.f};
        const int rb = lane >> 2, kq = lane & 3;
        __syncthreads();
        ScanRaw RW_;
        if (!consumer) { scan_issue(A, dir, b, h, half, 0, lane, RW_); scan_process(RW_, half, INc, BONc, lane, w2b, a2b, w0v, a0v, kkv, kav, rkv); scan_issue(A, dir, b, h, half, 1, lane, RW_); }
        __syncthreads();
        for (int c = 0; c < NCH; ++c) {
            if (consumer) {
                const LAS float* in = INc + (c & 1) * 6144;
                LAS float* yb = YBc + (c & 1) * 1024;
#pragma unroll 2
                for (int t = 0; t < 16; ++t) {
                    const LAS float* q = in + t * 64 + kq * 16;
                    f32x4 Wv[4], KDv[4], Bv[4], ANv[4], Rv[4];
#pragma unroll
                    for (int j = 0; j < 4; ++j) { Wv[j] = *(const LAS f32x4*)(q + 4 * j); KDv[j] = *(const LAS f32x4*)(q + 1024 + 4 * j); Bv[j] = *(const LAS f32x4*)(q + 2048 + 4 * j);
                                                  ANv[j] = *(const LAS f32x4*)(q + 3072 + 4 * j); Rv[j] = *(const LAS f32x4*)(q + 4096 + 4 * j); }
                    const f32x2 v2 = *(const LAS f32x2*)(in + 5120 + t * 64 + half * 32 + rb * 2);
#define PAIR(V, p) ((f32x2){V[(p) >> 1][((p) & 1) * 2], V[(p) >> 1][((p) & 1) * 2 + 1]})
                    float sa[2], y[2];
#pragma unroll
                    for (int i = 0; i < 2; ++i) { f32x2 a0 = {0.f, 0.f}, a1 = {0.f, 0.f};
#pragma unroll
                        for (int p = 0; p < 8; p += 2) { a0 += S2[i][p] * PAIR(ANv, p); a1 += S2[i][p + 1] * PAIR(ANv, p + 1); }
                        a0 += a1; sa[i] = red4(a0[0] + a0[1]); }
#pragma unroll
                    for (int i = 0; i < 2; ++i) { f32x2 y0 = {0.f, 0.f}, y1 = {0.f, 0.f}; const f32x2 sai = {sa[i], sa[i]}, vi = {v2[i], v2[i]};
#pragma unroll
                        for (int p = 0; p < 8; p += 2) {
                            const f32x2 n0 = S2[i][p] * PAIR(Wv, p) + sai * PAIR(Bv, p) + vi * PAIR(KDv, p);
                            const f32x2 n1 = S2[i][p + 1] * PAIR(Wv, p + 1) + sai * PAIR(Bv, p + 1) + vi * PAIR(KDv, p + 1);
                            S2[i][p] = n0; S2[i][p + 1] = n1; y0 += n0 * PAIR(Rv, p); y1 += n1 * PAIR(Rv, p + 1); }
                        y0 += y1; y[i] = red4(y0[0] + y0[1]); }
#undef PAIR
                    if (kq == 0) *(LAS f32x2*)(yb + t * 64 + half * 32 + rb * 2) = (f32x2){y[0], y[1]};
                }
            } else {
                if (half == 0 && lane < 16) {
                    const LAS float* bo = BONc + (c & 1) * 32;
                    const size_t m = (size_t)b * PB + scan_row(dir, c * 16 + lane);
                    A.CB[(size_t)dir * MR * 16 + m * 16 + h] = bo[lane] + bo[16 + lane];
                }
                if (c >= 1) {
                    const int t = half * 8 + (lane >> 3), c8 = (lane & 7) * 8;
                    const LAS float* yb = YBc + ((c - 1) & 1) * 1024 + t * 64 + c8;
                    float f[8];
#pragma unroll
                    for (int i = 0; i < 8; ++i) f[i] = yb[i];
                    const size_t m = (size_t)b * PB + scan_row(dir, (c - 1) * 16 + t);
                    *(u32x4*)(Yd + m * DM + h * 64 + c8) = pack8(f);
                }
                if (c + 1 < NCH) { scan_process(RW_, half, INc + ((c + 1) & 1) * 6144, BONc + ((c + 1) & 1) * 32, lane, w2b, a2b, w0v, a0v, kkv, kav, rkv);
                                   if (c + 2 < NCH) scan_issue(A, dir, b, h, half, c + 2, lane, RW_); }
            }
            __syncthreads();
        }
        if (!consumer) {
            const int c = NCH;
            const int t = half * 8 + (lane >> 3), c8 = (lane & 7) * 8;
            const LAS float* yb = YBc + ((c - 1) & 1) * 1024 + t * 64 + c8;
            float f[8];
#pragma unroll
            for (int i = 0; i < 8; ++i) f[i] = yb[i];
            const size_t m = (size_t)b * PB + scan_row(dir, (c - 1) * 16 + t);
            *(u32x4*)(Yd + m * DM + h * 64 + c8) = pack8(f);
        }
        __syncthreads();
    }
}

enum { ST_NOP = 0, ST_P0, ST_NORM, ST_GEMM, ST_ATTN, ST_MIX, ST_SCAN, ST_POST, ST_CONV, ST_FINAL };
struct Step {
    int type, sync;
    pg8::Gemm g; EpiGen e;
    int i0, i1, i2;
    bf16_t* Vb;
};
constexpr int NSTEPS = 1 + 2 * 8 + 2 * 20 + 1;

__host__ __device__ __forceinline__ void make_step(int st, const Params& P, unsigned char* ws, Step& S) {
    const float* MOD = (const float*)(ws + WS_MOD);
    bf16_t* A0 = (bf16_t*)(ws + WS_A0); bf16_t* A1 = (bf16_t*)(ws + WS_A1); bf16_t* A2 = (bf16_t*)(ws + WS_A2); bf16_t* A3 = (bf16_t*)(ws + WS_A3); bf16_t* A4 = (bf16_t*)(ws + WS_A4);
    bf16_t* VF = (bf16_t*)(ws + WS_VF);
    bf16_t* WLb = (bf16_t*)(ws + WS_LORA); bf16_t* ALb = (bf16_t*)(ws + WS_LORA + LORA_SZ); bf16_t* GLb = (bf16_t*)(ws + WS_LORA + 2 * LORA_SZ); bf16_t* VLb = (bf16_t*)(ws + WS_LORA + 3 * LORA_SZ);
    const unsigned char* WB = ws + WS_W;
    S.type = ST_NOP; S.sync = 0; S.i0 = S.i1 = S.i2 = 0; S.Vb = nullptr;
    S.g = pg8::Gemm{nullptr, nullptr, MR, DM, DM, DM, DM, 0, 0};
    S.e = EpiGen{EM_BF16, nullptr, nullptr, nullptr, nullptr, nullptr, nullptr, P.out, (float*)(ws + WS_CTXR), DM, DM, 0, 0, 0, 0u};
    if (st == 0) { S.type = ST_P0; S.sync = 1; return; }
    if (st == NSTEPS - 1) { S.type = ST_FINAL; return; }
    int r = st - 1, layer = 0;
    for (;; ++layer) { const int len = (layer & 1) ? 20 : 8; if (r < len) break; r -= len; }
    const int j = layer >> 1; const bool rw = layer & 1; const int lastl = (layer == NLAYER - 1) ? 1 : 0;
    const float* mod = MOD + (size_t)layer * 17 * 6144;
    const int nmix = rw ? 16 : 4;
    if (r == 0) { S.type = ST_NORM; S.sync = 1; S.i0 = layer; S.i1 = 0; S.i2 = (layer == 0); return; }
    if (r >= nmix) {
        const int f = r - nmix;
        if (f == 0) { S.type = ST_NORM; S.sync = 1; S.i0 = layer; S.i1 = 1; S.i2 = 0; return; }
        bf16_t* HALO = A4; bf16_t* HB = (bf16_t*)(ws + WS_A4 + 16 * MiB);
        if (f == 1) { S.type = ST_GEMM; S.sync = 1; S.g = pg8::Gemm{HB, (const bf16_t*)(WB + W_UP2(layer)), 768, 2 * DFF, DM, DM, DM, 0, 0}; S.e.mode = EM_BF16; S.e.O = HALO; S.e.ldc = 2 * DFF; S.e.nstore = 2 * DFF; S.e.act = 0; }
        else if (f == 2) { S.type = ST_GEMM; S.sync = 1; S.g = pg8::Gemm{A0, (const bf16_t*)(WB + W_UP2(layer)), lastl ? NB * TL : MR, 2 * DFF, DM, DM, DM, 0, lastl}; S.e.mode = EM_GLU; S.e.O = A1; S.e.VFp = HALO;
                      S.e.f0 = P.in[9] + (size_t)layer * 3 * DFF; S.e.f1 = P.in[10] + (size_t)layer * DFF; }
        else { S.type = ST_GEMM; S.sync = 1; S.g = pg8::Gemm{A1, (const bf16_t*)(WB + W_DN2(layer)), lastl ? NB * TL : MR, DM, DFF, DFF, DFF, 0, lastl}; S.e.mode = EM_RES; S.e.f0 = mod; S.e.k = 5; S.e.row_off = 0; }
        return;
    }
    if (!rw) {
        if (r == 1) { S.type = ST_GEMM; S.sync = 1; S.g = pg8::Gemm{A0, (const bf16_t*)(WB + W_QKV(j)), MR, 3072, DM, DM, DM, 0, 0}; S.e.mode = EM_QKV; S.e.O = A1; S.e.O2 = A2; S.e.O3 = A3; S.e.f0 = (const float*)(ws + WS_ROPE); }
        else if (r == 2) { S.type = ST_ATTN; S.sync = 1; S.i0 = j; S.i1 = layer; }
        else { S.type = ST_GEMM; S.sync = 1; S.g = pg8::Gemm{A0, (const bf16_t*)(WB + W_AO(j)), MR, DM, DM, DM, DM, 0, 0}; S.e.mode = EM_RES; S.e.f0 = mod; S.e.k = 2; S.e.row_off = 0; }
        return;
    }
    const unsigned char* RW = WB + W_RWB(j);
    bf16_t* Vb = (j == 0) ? VF : A3; S.Vb = Vb;
    switch (r) {
    case 1: S.type = ST_MIX; S.sync = 1; S.i0 = 2; S.i1 = 3; S.i2 = j; break;
    case 2: S.type = ST_GEMM; S.g = pg8::Gemm{A1, (const bf16_t*)(RW + RW_K), MR, DM, DM, DM, DM, 0, 0}; S.e.O = A4; break;
    case 3: S.type = ST_GEMM; S.g = pg8::Gemm{A2, (const bf16_t*)(RW + RW_V), MR, DM, DM, DM, DM, 192, 0}; S.e.O = Vb; break;
    case 4: S.sync = 1; if (j > 0) { S.type = ST_GEMM; S.g = pg8::Gemm{A2, (const bf16_t*)(RW + RW_V1), MR, 256, DM, DM, DM, 128, 0}; S.e.O = VLb; S.e.ldc = 128; S.e.nstore = 128; } break;
    case 5: S.type = ST_MIX; S.sync = 1; S.i0 = 1; S.i1 = 4; S.i2 = j | 256; break;
    case 6: S.type = ST_GEMM; S.g = pg8::Gemm{A1, (const bf16_t*)(RW + RW_W1), MR, 256, DM, DM, DM, 0, 0}; S.e.O = WLb; S.e.ldc = 128; S.e.nstore = 128; S.e.act = 1; break;
    case 7: S.type = ST_GEMM; S.g = pg8::Gemm{A2, (const bf16_t*)(RW + RW_A1), MR, 256, DM, DM, DM, 240, 0}; S.e.O = ALb; S.e.ldc = 128; S.e.nstore = 128; break;
    case 8: S.sync = 1; if (j > 0) { S.type = ST_GEMM; S.g = pg8::Gemm{VLb, (const bf16_t*)(RW + RW_V2), MR, DM, 128, 128, 128, 224, 0}; S.e.mode = EM_VMIX; S.e.O = Vb; S.e.VFp = VF; S.e.f0 = P.in[27] + (size_t)(j - 1) * DM; } break;
    case 9: S.type = ST_MIX; S.sync = 1; S.i0 = 5; S.i1 = 0; S.i2 = j; break;
    case 10: S.type = ST_GEMM; S.g = pg8::Gemm{A1, (const bf16_t*)(RW + RW_G1), MR, 256, DM, DM, DM, 0, 0}; S.e.O = GLb; S.e.ldc = 128; S.e.nstore = 128; S.e.act = 2; break;
    case 11: S.type = ST_GEMM; S.sync = 1; S.g = pg8::Gemm{A2, (const bf16_t*)(RW + RW_R), MR, DM, DM, DM, DM, 240, 0}; S.e.O = A0; break;
    case 12: S.type = ST_SCAN; S.sync = 1; S.i0 = j; break;
    case 13: S.type = ST_POST; S.sync = 1; S.i0 = j; break;
    case 14: S.type = ST_GEMM; S.sync = 1; S.g = pg8::Gemm{GLb, (const bf16_t*)(RW + RW_G2), lastl ? NB * TL : MR, DM, 128, 128, 128, 0, lastl}; S.e.mode = EM_MULZ; S.e.O = A4; break;
    default: S.type = ST_GEMM; S.sync = 1; S.g = pg8::Gemm{A4, (const bf16_t*)(RW + RW_O), lastl ? NB * TL : MR, DM, DM, DM, DM, 0, lastl}; S.e.mode = EM_RES; S.e.f0 = mod; S.e.k = 2; S.e.row_off = 0; break;
    }
}

template <int TYPE> __device__ __forceinline__ void run_step(const Params& P, unsigned char* ws, const Step& S, LAS unsigned char* lds, unsigned char* lds_raw) {
    float* XL = P.out; float* XC = (float*)(ws + WS_CTXR);
    bf16_t* A0 = (bf16_t*)(ws + WS_A0); bf16_t* A1 = (bf16_t*)(ws + WS_A1); bf16_t* A2 = (bf16_t*)(ws + WS_A2); bf16_t* A3 = (bf16_t*)(ws + WS_A3); bf16_t* A4 = (bf16_t*)(ws + WS_A4);
    const float* MOD = (const float*)(ws + WS_MOD);
    float* KN = (float*)(ws + WS_KNORM); float* CB = (float*)(ws + WS_CB2);
    if constexpr (TYPE == ST_P0) { phase_p0(P, ws, lds); }
    else if constexpr (TYPE == ST_NORM) {
        const int layer = S.i0; const float* mod = MOD + (size_t)layer * 17 * 6144;
        const float* g = (S.i1 ? P.in[7] : P.in[6]) + layer * DM;
        bf16_t* HB = S.i1 ? (bf16_t*)(ws + WS_A4 + 16 * MiB) : nullptr;
        if (S.i2) phase_norm_mod(P.in[0], P.in[2], XL, XC, g, mod, S.i1, A0, HB);
        else phase_norm_mod(XL, XC, nullptr, nullptr, g, mod, S.i1, A0, HB);
    }
    else if constexpr (TYPE == ST_GEMM) { EpiGen e = S.e; e.ldsb = (unsigned)(uintptr_t)lds + 131072u; pg8::gemm_phase(lds, S.g, e); }
    else if constexpr (TYPE == ST_ATTN) {
        const int j = S.i0; const float lambda_init = (S.i1 == 0) ? 0.2f : 0.47071301835f;
        phase_attn(A1, A2, A3, A0, (float*)A4, P.in[13] + j * 256, lambda_init, P.in[14] + j * 128, (char*)lds_raw);
    }
    else if constexpr (TYPE == ST_MIX) {
        const int j = S.i2 & 255; const bool kn = (S.i2 & 256) != 0;
        const float* mp = P.in[16] + (size_t)j * 6 * DM; const float* mn = P.in[17] + (size_t)j * 6 * DM;
        phase_mix(A0, mp, mn, S.i0, S.i1, A1, A2, kn ? A4 : nullptr, P.in[30] + j * DM, kn ? KN : nullptr);
    }
    else if constexpr (TYPE == ST_SCAN) {
        const int j = S.i0; const unsigned char* RW = ws + WS_W + W_RWB(j);
        ScanArgs SA{A0, A4, S.Vb, (bf16_t*)(ws + WS_LORA), (bf16_t*)(ws + WS_LORA + LORA_SZ), KN, (const bf16_t*)(RW + RW_W2), (const bf16_t*)(RW + RW_A2), P.in[21] + (size_t)j * 2 * DM, P.in[24] + (size_t)j * 2 * DM,
                    P.in[30] + j * DM, P.in[31] + j * DM, P.in[32] + j * DM, A1, A2, CB};
        phase_scan(SA, lds);
    }
    else if constexpr (TYPE == ST_POST) { const int j = S.i0; phase_post(A1, A2, S.Vb, CB, P.in[35] + j * DM, P.in[36] + j * DM, A4); }
    else if constexpr (TYPE == ST_CONV) { const int layer = S.i0; phase_convact(A1, A4, S.i1, S.i2, P.in[9] + (size_t)layer * 3 * DFF, P.in[10] + (size_t)layer * DFF); }
    else if constexpr (TYPE == ST_FINAL) { phase_final_norm(XL, P.in[38]); }
}

#ifndef FUSED
#define FUSED 1
#endif
#if FUSED
__global__ void __launch_bounds__(NTHR, 2) fwd_megakernel(Params P) {
    extern __shared__ __attribute__((aligned(16))) unsigned char lds_raw[];
    LAS unsigned char* lds = (LAS unsigned char*)lds_raw;
    cg::grid_group grid = cg::this_grid();
    volatile LAS unsigned* bst = (volatile LAS unsigned*)(lds + 147456);
    if (threadIdx.x < 2) bst[threadIdx.x] = 0u;
    __syncthreads();
    (void)xcd_barrier_post((unsigned*)(P.ws + WS_BAR), bst);
    for (int st = 0; st < NSTEPS; ++st) {
        unsigned char* ws;
        { unsigned lo = P.ws_lo, hi = P.ws_hi;
          asm volatile("" : "+s"(lo), "+s"(hi));
          typedef __attribute__((address_space(1))) unsigned char gbyte_t;
          ws = (unsigned char*)(gbyte_t*)(((uintptr_t)hi << 32) | (uintptr_t)lo); }
        Step S; make_step(st, P, ws, S);
        switch (S.type) {
        case ST_P0: run_step<ST_P0>(P, ws, S, lds, lds_raw); break;
        case ST_NORM: run_step<ST_NORM>(P, ws, S, lds, lds_raw); break;
        case ST_GEMM: run_step<ST_GEMM>(P, ws, S, lds, lds_raw); break;
        case ST_ATTN: run_step<ST_ATTN>(P, ws, S, lds, lds_raw); break;
        case ST_MIX: run_step<ST_MIX>(P, ws, S, lds, lds_raw); break;
        case ST_SCAN: run_step<ST_SCAN>(P, ws, S, lds, lds_raw); break;
        case ST_POST: run_step<ST_POST>(P, ws, S, lds, lds_raw); break;
        case ST_CONV: run_step<ST_CONV>(P, ws, S, lds, lds_raw); break;
        case ST_FINAL: run_step<ST_FINAL>(P, ws, S, lds, lds_raw); break;
        default: break;
        }
#if defined(PROBE_DUP)
        if (S.type == PROBE_DUP) {
            grid.sync();
            switch (S.type) {
            case ST_ATTN: run_step<ST_ATTN>(P, ws, S, lds, lds_raw); break;
            case ST_SCAN: run_step<ST_SCAN>(P, ws, S, lds, lds_raw); break;
            case ST_CONV: run_step<ST_CONV>(P, ws, S, lds, lds_raw); break;
            case ST_MIX: run_step<ST_MIX>(P, ws, S, lds, lds_raw); break;
            case ST_NORM: run_step<ST_NORM>(P, ws, S, lds, lds_raw); break;
            case ST_POST: run_step<ST_POST>(P, ws, S, lds, lds_raw); break;
            case ST_P0: run_step<ST_P0>(P, ws, S, lds, lds_raw); break;
            default: break;
            }
        }
#endif
        if (S.sync) { if (st == 0) grid.sync(); else { XcdBarrier xb; xb.bar = (unsigned*)(ws + WS_BAR); xb.x = xb_xcc_id(); xb.st = (volatile LAS unsigned*)(lds + 147456); xcd_barrier(xb); } }
#if defined(PROBE_SYNC)
        if (S.sync) { grid.sync(); grid.sync(); }
#endif
    }
}
#else
template <int TYPE> __global__ void __launch_bounds__(NTHR, 2) k_step(Params P, int st) {
    extern __shared__ __attribute__((aligned(16))) unsigned char lds_raw[];
    LAS unsigned char* lds = (LAS unsigned char*)lds_raw;
    Step S; make_step(st, P, P.ws, S);
    run_step<TYPE>(P, P.ws, S, lds, lds_raw);
}
template <int TYPE> static void launch_step(const Params& P, int st, int grid, hipStream_t stream) {
    static bool attr_done = false;
    if (!attr_done) { (void)hipFuncSetAttribute((const void*)k_step<TYPE>, hipFuncAttributeMaxDynamicSharedMemorySize, LDS_BYTES); attr_done = true; }
    hipLaunchKernelGGL(k_step<TYPE>, dim3(grid), dim3(NTHR), LDS_BYTES, stream, P, st);
}
#endif

extern "C" void kernel_launch(void* const* d_in, const int* in_sizes, int n_in, void* d_out, int out_size, void* d_ws, size_t ws_size, hipStream_t stream) {
    static int grid = 0;
    if (grid == 0) {
        if (n_in != 39 || out_size != NB * TL * DM || ws_size < WS_END) { fprintf(stderr, "kernel_launch: unexpected shapes n_in %d out %d ws %zu (need %zu)\n", n_in, out_size, ws_size, (size_t)WS_END); grid = -1; return; }
        int dev = 0, cus = 0, per_cu = 1;
        (void)hipGetDevice(&dev); (void)hipDeviceGetAttribute(&cus, hipDeviceAttributeMultiprocessorCount, dev);
#if FUSED
        if (hipFuncSetAttribute((const void*)fwd_megakernel, hipFuncAttributeMaxDynamicSharedMemorySize, LDS_BYTES) != hipSuccess) { fprintf(stderr, "kernel_launch: hipFuncSetAttribute failed\n"); grid = -1; return; }
        if (hipOccupancyMaxActiveBlocksPerMultiprocessor(&per_cu, (const void*)fwd_megakernel, NTHR, LDS_BYTES) != hipSuccess || per_cu < 1) { fprintf(stderr, "kernel_launch: occupancy query gave %d\n", per_cu); per_cu = 1; }
        (void)hipGetLastError();
#endif
        grid = cus * per_cu;
        fprintf(stderr, "kernel_launch: grid %d (cus %d x %d), ws %zu\n", grid, cus, per_cu, ws_size);
    }
    if (grid < 0) return;
    Params P; memset(&P, 0, sizeof(P));
    for (int i = 0; i < 39; ++i) P.in[i] = (const float*)d_in[i];
    P.out = (float*)d_out; P.ws = (unsigned char*)d_ws; P.ws_lo = (unsigned)((uintptr_t)d_ws & 0xffffffffu); P.ws_hi = (unsigned)((uintptr_t)d_ws >> 32);
    unsigned char* WBh = (unsigned char*)d_ws + WS_W;
    int nj = 0;
    auto add = [&](const float* src, size_t dst_off, int Ksrc, int Kdst, int Nsrc, int Ndst, int dld, int perm) {
        TJob& J = P.jobs[nj++]; J.src = src; J.dst = (bf16_t*)(WBh + dst_off); J.Ksrc = Ksrc; J.Kdst = Kdst; J.Nsrc = Nsrc; J.Ndst = Ndst; J.dld = dld; J.perm = perm; };
    for (int j = 0; j < 2; ++j) {
        add(P.in[12] + (size_t)j * DM * 3072, W_QKV(j), DM, DM, 3072, 3072, DM, 1);
        add(P.in[15] + (size_t)j * DM * DM, W_AO(j), DM, DM, DM, DM, DM, 0);
    }
    for (int i = 0; i < 4; ++i) {
        add(P.in[8] + (size_t)i * DM * 2 * DFF, W_UP2(i), DM, DM, 2 * DFF, 2 * DFF, DM, 2);
        add(P.in[11] + (size_t)i * DFF * DM, W_DN2(i), DFF, DFF, DM, DM, DFF, 0);
    }
    for (int j = 0; j < 2; ++j) {
        const size_t rb = W_RWB(j);
        add(P.in[18] + (size_t)j * DM * DM, rb + RW_R, DM, DM, DM, DM, DM, 0);
        add(P.in[19] + (size_t)j * DM * DM, rb + RW_K, DM, DM, DM, DM, DM, 0);
        add(P.in[20] + (size_t)j * DM * DM, rb + RW_V, DM, DM, DM, DM, DM, 0);
        add(P.in[37] + (size_t)j * DM * DM, rb + RW_O, DM, DM, DM, DM, DM, 0);
        add(P.in[22] + ((size_t)j * 2 + 0) * DM * 64, rb + RW_W1, DM, DM, 64, 64, DM, 0);
        add(P.in[22] + ((size_t)j * 2 + 1) * DM * 64, rb + RW_W1 + (size_t)64 * DM * 2, DM, DM, 64, 192, DM, 0);
        add(P.in[25] + ((size_t)j * 2 + 0) * DM * 64, rb + RW_A1, DM, DM, 64, 64, DM, 0);
        add(P.in[25] + ((size_t)j * 2 + 1) * DM * 64, rb + RW_A1 + (size_t)64 * DM * 2, DM, DM, 64, 192, DM, 0);
        add(P.in[33] + (size_t)j * DM * 128, rb + RW_G1, DM, DM, 128, 256, DM, 0);
        if (j > 0) add(P.in[28] + (size_t)(j - 1) * DM * 32, rb + RW_V1, DM, DM, 32, 256, DM, 0);
        add(P.in[34] + (size_t)j * 128 * DM, rb + RW_G2, 128, 128, DM, DM, 128, 0);
        if (j > 0) add(P.in[29] + (size_t)(j - 1) * 32 * DM, rb + RW_V2, 32, 128, DM, DM, 128, 0);
        for (int d = 0; d < 2; ++d) {
            add(P.in[23] + ((size_t)j * 2 + d) * 64 * DM, rb + RW_W2 + (size_t)d * DM * 64 * 2, 64, 64, DM, DM, 64, 0);
            add(P.in[26] + ((size_t)j * 2 + d) * 64 * DM, rb + RW_A2 + (size_t)d * DM * 64 * 2, 64, 64, DM, DM, 64, 0);
        }
    }
    P.njobs = nj;
#if FUSED
    (void)hipMemsetAsync((char*)d_ws + WS_BAR, 0, 16384, stream);
    void* args[] = {&P};
    hipError_t e = hipLaunchCooperativeKernel((const void*)fwd_megakernel, dim3(grid), dim3(NTHR), args, LDS_BYTES, stream);
    if (e != hipSuccess) fprintf(stderr, "cooperative launch failed: %s (grid %d)\n", hipGetErrorString(e), grid);
#else
    for (int st = 0; st < NSTEPS; ++st) {
        Step S; make_step(st, P, P.ws, S);
        switch (S.type) {
        case ST_P0: launch_step<ST_P0>(P, st, grid, stream); break;
        case ST_NORM: launch_step<ST_NORM>(P, st, grid, stream); break;
        case ST_GEMM: launch_step<ST_GEMM>(P, st, grid, stream); break;
        case ST_ATTN: launch_step<ST_ATTN>(P, st, grid, stream); break;
        case ST_MIX: launch_step<ST_MIX>(P, st, grid, stream); break;
        case ST_SCAN: launch_step<ST_SCAN>(P, st, grid, stream); break;
        case ST_POST: launch_step<ST_POST>(P, st, grid, stream); break;
        case ST_CONV: launch_step<ST_CONV>(P, st, grid, stream); break;
        case ST_FINAL: launch_step<ST_FINAL>(P, st, grid, stream); break;
        default: break;
        }
    }
#endif
}
```
